# Optimizing an MI355X kernel written in HIP

```python
import functools
import jax, jax.numpy as jnp
from jax import lax
import numpy as np

D_MODEL = 2048
BATCH = 32
SEQ = 256
DEPTH = 4
DEC_BATCH = 4
DEC_SEQ = 1024
PAST_LEN = 512

GRID_W = 64
N_MIXERS = 2
N_MLA = (DEPTH + 1) // 2
N_RWKV = DEPTH // 2
D_FF = 5632
N_MOD = 9
RMS_EPS = 1e-6
MLA_HEADS = 16
Q_LORA = 512
KV_LORA = 512
QK_NOPE = 128
QK_ROPE = 64
V_DIM = 128
ROPE_FREQS = QK_ROPE // 4
ROPE_THETA = 10000.0
Q_BLOCK = 128
ATTN_SCALE = (QK_NOPE + QK_ROPE) ** -0.5
RWKV_HEAD = 64
RWKV_HEADS = D_MODEL // RWKV_HEAD
DECAY_LORA = 96
A_LORA = 96
G_LORA = 256
GN_EPS = 64e-5

kernel_name = "hybrid_mla_rwkv7_prefix_diffusion_step"


def _rmsnorm(x, w):
    xf = x.astype(jnp.float32)
    y = xf * lax.rsqrt(jnp.mean(xf * xf, axis=-1, keepdims=True) + RMS_EPS)
    return (y * w.astype(jnp.float32)).astype(x.dtype)


def _modulate(x, g, shift, scale):
    return _rmsnorm(x, g) * (1 + scale) + shift


def _swiglu(h, w_in, w_out):
    gate, up = jnp.split(h @ w_in, 2, axis=-1)
    return (jax.nn.silu(gate) * up) @ w_out


def _axial_angles(n_tokens):
    rows = n_tokens // GRID_W
    row = jnp.repeat(jnp.arange(rows, dtype=jnp.float32), GRID_W)
    col = jnp.tile(jnp.arange(GRID_W, dtype=jnp.float32), rows)
    inv = ROPE_THETA ** (-jnp.arange(ROPE_FREQS, dtype=jnp.float32) / ROPE_FREQS)
    ang = jnp.stack([row[:, None] * inv, col[:, None] * inv], axis=1)[:, :, None, :]
    return jnp.cos(ang), jnp.sin(ang)


def _axial_rope(x, cos, sin):
    shp = x.shape
    xr = x.reshape(shp[:-1] + (2, 2, ROPE_FREQS))
    rot = jnp.stack([-xr[..., 1, :], xr[..., 0, :]], axis=-2)
    out = xr * cos.astype(x.dtype) + rot * sin.astype(x.dtype)
    return out.reshape(shp)


def _attend(q_nope, q_rope, k_nope, k_rope, v):
    B, S, H, _ = q_nope.shape
    blk = min(Q_BLOCK, S)
    nb = S // blk
    qn = q_nope.reshape(B, nb, blk, H, QK_NOPE).swapaxes(0, 1)
    qr = q_rope.reshape(B, nb, blk, H, QK_ROPE).swapaxes(0, 1)

    def one(args):
        qn_b, qr_b = args
        s = (jnp.einsum('bqhd,bkhd->bhqk', qn_b, k_nope, preferred_element_type=jnp.float32)
             + jnp.einsum('bqhr,bkr->bhqk', qr_b, k_rope, preferred_element_type=jnp.float32)) * ATTN_SCALE
        pr = jax.nn.softmax(s, axis=-1).astype(v.dtype)
        return jnp.einsum('bhqk,bkhd->bqhd', pr, v)

    o = lax.map(one, (qn, qr))
    return o.swapaxes(0, 1).reshape(B, S, H, V_DIM)


def _mla_q(h, p, j):
    B, S, _ = h.shape
    cq = _rmsnorm(h @ p['mla_w_dq'][j], p['mla_q_norm'][j])
    q = (cq @ p['mla_w_uq'][j]).reshape(B, S, MLA_HEADS, QK_NOPE + QK_ROPE)
    return q[..., :QK_NOPE], q[..., QK_NOPE:]


def _mla_kv(h, p, j):
    kv = h @ p['mla_w_dkv'][j]
    return _rmsnorm(kv[..., :KV_LORA], p['mla_kv_norm'][j]), kv[..., KV_LORA:]


def _mla_expand(ckv, p, j):
    B, T, _ = ckv.shape
    kv = (ckv @ p['mla_w_ukv'][j]).reshape(B, T, MLA_HEADS, QK_NOPE + V_DIM)
    return kv[..., :QK_NOPE], kv[..., QK_NOPE:]


def _mla_out(o, p, j):
    B, S = o.shape[:2]
    return o.reshape(B, S, MLA_HEADS * V_DIM) @ p['mla_w_o'][j]


def _mla_context(h, p, j):
    qn, qr = _mla_q(h, p, j)
    ckv, kr = _mla_kv(h, p, j)
    kn, v = _mla_expand(ckv, p, j)
    return _mla_out(_attend(qn, qr, kn, kr, v), p, j), (ckv, kr)


def _mla_latent(h, ctx_ckv, ctx_krope, cos, sin, p, j):
    qn, qr = _mla_q(h, p, j)
    qr = _axial_rope(qr, cos[:, None], sin[:, None])
    ckv, kr = _mla_kv(h, p, j)
    kr = _axial_rope(kr, cos, sin)
    ckv = jnp.concatenate([ctx_ckv.astype(ckv.dtype), ckv], axis=1)
    kr = jnp.concatenate([ctx_krope.astype(kr.dtype), kr], axis=1)
    kn, v = _mla_expand(ckv, p, j)
    return _mla_out(_attend(qn, qr, kn, kr, v), p, j), None


def _wkv_scan(r, w, k, v, a, b, s0, reverse):
    def step(S, inp):
        r_t, w_t, k_t, v_t, a_t, b_t = inp
        sa = jnp.einsum('bhij,bhj->bhi', S, a_t)
        S = S * w_t[:, :, None, :] + sa[..., None] * b_t[:, :, None, :] + v_t[..., None] * k_t[:, :, None, :]
        return S, jnp.einsum('bhij,bhj->bhi', S, r_t)

    xs = tuple(jnp.moveaxis(t, 1, 0) for t in (r, w, k, v, a, b))
    s_final, ys = lax.scan(step, s0.astype(jnp.float32), xs, reverse=reverse)
    return jnp.moveaxis(ys, 0, 1), s_final


def _rwkv_mix(h, s0_fwd, s0_bwd, p, j):
    B, T, D = h.shape
    H, N = RWKV_HEADS, RWKV_HEAD
    f32 = jnp.float32
    hp = jnp.pad(h, ((0, 0), (1, 1), (0, 0)))
    xx = 0.5 * (hp[:, :-2] + hp[:, 2:]) - h
    mu = p['rwkv_mu'][j]
    xr, xk, xv, xg = (h + xx * mu[i] for i in range(4))
    r = (xr @ p['rwkv_w_r'][j]).astype(f32).reshape(B, T, H, N)
    k = (xk @ p['rwkv_w_k'][j]).astype(f32).reshape(B, T, H, N)
    v = (xv @ p['rwkv_w_v'][j]).astype(f32).reshape(B, T, H, N)
    g = jax.nn.sigmoid(xg @ p['rwkv_g1'][j]) @ p['rwkv_g2'][j]
    kk = k * p['rwkv_k_k'][j].astype(f32).reshape(H, N)
    kk = kk / jnp.maximum(jnp.linalg.norm(kk, axis=-1, keepdims=True), 1e-12)
    k_a = p['rwkv_k_a'][j].astype(f32).reshape(H, N)
    r_k = p['rwkv_r_k'][j].astype(f32)
    y = jnp.zeros((B, T, H, N), f32)
    bonus = jnp.zeros((B, T, H, N), f32)
    finals = []
    for d, s0 in enumerate((s0_fwd, s0_bwd)):
        xw = h + xx * p['rwkv_mu_dir'][j, d, 0]
        xa = h + xx * p['rwkv_mu_dir'][j, d, 1]
        w_log = -jax.nn.softplus(-(p['rwkv_w0'][j, d] + jnp.tanh(xw @ p['rwkv_w1'][j, d]) @ p['rwkv_w2'][j, d])) - 0.5
        decay = jnp.exp(-jnp.exp(w_log.astype(f32))).reshape(B, T, H, N)
        a = jax.nn.sigmoid(p['rwkv_a0'][j, d] + (xa @ p['rwkv_a1'][j, d]) @ p['rwkv_a2'][j, d]).astype(f32).reshape(B, T, H, N)
        kd = k * (1 + (a - 1) * k_a)
        yd, s_final = _wkv_scan(r, decay, kd, v, -kk, kk * a, s0, reverse=(d == 1))
        y = y + yd
        bonus = bonus + jnp.sum(r * kd * r_k, axis=-1, keepdims=True) * v
        finals.append(s_final)
    mean = jnp.mean(y, axis=-1, keepdims=True)
    var = jnp.mean(jnp.square(y - mean), axis=-1, keepdims=True)
    yn = ((y - mean) * lax.rsqrt(var + GN_EPS)).reshape(B, T, D)
    yn = yn * p['rwkv_ln_w'][j].astype(f32) + p['rwkv_ln_b'][j].astype(f32)
    o = (yn + bonus.reshape(B, T, D)).astype(h.dtype)
    return (o * g) @ p['rwkv_w_o'][j], (finals[0], finals[1])


def _layer(x, cond, l, p, mix):
    m = (jax.nn.silu(cond) @ p['w_ada'][l] + p['b_ada'][l]).reshape(cond.shape[0], 1, N_MOD, D_MODEL)
    h = _modulate(x, p['norm_sub'][l, 0], m[:, :, 0], m[:, :, 1])
    x = x + 0.5 * m[:, :, 2] * _swiglu(h, p['w_ffn_in'][l, 0], p['w_ffn_out'][l, 0])
    h = _modulate(x, p['norm_sub'][l, 1], m[:, :, 3], m[:, :, 4])
    out, extra = mix(h)
    x = x + m[:, :, 5] * out
    h = _modulate(x, p['norm_sub'][l, 2], m[:, :, 6], m[:, :, 7])
    x = x + 0.5 * m[:, :, 8] * _swiglu(h, p['w_ffn_in'][l, 1], p['w_ffn_out'][l, 1])
    return x, extra


def _context_pass(x, c_ctx, p):
    cond = c_ctx[None, :]
    zero = jnp.zeros((x.shape[0], RWKV_HEADS, RWKV_HEAD, RWKV_HEAD), jnp.float32)
    ckv_l, kr_l, sf_l, sb_l = [], [], [], []
    for l in range(DEPTH):
        j = l // N_MIXERS
        if l % N_MIXERS == 0:
            mix = functools.partial(_mla_context, p=p, j=j)
        else:
            mix = functools.partial(_rwkv_mix, s0_fwd=zero, s0_bwd=zero, p=p, j=j)
        x, extra = _layer(x, cond, l, p, mix)
        if l % N_MIXERS == 0:
            ckv_l.append(extra[0])
            kr_l.append(extra[1])
        else:
            sf_l.append(extra[0])
            sb_l.append(extra[1])
    y = _rmsnorm(x, p['norm_final'])
    return y, jnp.stack(ckv_l, axis=1), jnp.stack(kr_l, axis=1), jnp.stack(sf_l, axis=1), jnp.stack(sb_l, axis=1)


def _latent_pass(x, c, cache_ckv, cache_krope, state_fwd, state_bwd, p):
    cos, sin = _axial_angles(x.shape[1])
    for l in range(DEPTH):
        j = l // N_MIXERS
        if l % N_MIXERS == 0:
            mix = functools.partial(_mla_latent, ctx_ckv=cache_ckv[:, j], ctx_krope=cache_krope[:, j],
                                    cos=cos, sin=sin, p=p, j=j)
        else:
            mix = functools.partial(_rwkv_mix, s0_fwd=state_fwd[:, j], s0_bwd=state_bwd[:, j], p=p, j=j)
        x, _ = _layer(x, c, l, p, mix)
    return _rmsnorm(x, p['norm_final'])


def setup_inputs(seed: int = 0) -> dict:
    key = jax.random.key(seed)
    ks = iter(jax.random.split(key, 48))

    def nrm(shape, scale=1.0):
        return jax.random.normal(next(ks), shape, jnp.float32) * scale

    def uni(shape, lo, hi):
        return jax.random.uniform(next(ks), shape, jnp.float32, lo, hi)

    D, H, RH, N = D_MODEL, MLA_HEADS, RWKV_HEADS, RWKV_HEAD
    return {
        'x_prompt': nrm((BATCH, SEQ, D)),
        'x_sample': nrm((DEC_BATCH, DEC_SEQ, D)),
        'cache_ckv': nrm((DEC_BATCH, N_MLA, PAST_LEN, KV_LORA)),
        'cache_krope': nrm((DEC_BATCH, N_MLA, PAST_LEN, QK_ROPE)),
        'state_wkv_fwd': nrm((DEC_BATCH, N_RWKV, RH, N, N), 0.5),
        'state_wkv_bwd': nrm((DEC_BATCH, N_RWKV, RH, N, N), 0.5),
        'c': nrm((DEC_BATCH, D)),
        'c_ctx': nrm((D,)),
        'w_ada': nrm((DEPTH, D, N_MOD * D), 0.5 * D ** -0.5),
        'b_ada': nrm((DEPTH, N_MOD * D), 0.02),
        'norm_sub': 1 + nrm((DEPTH, 3, D), 0.02),
        'norm_final': 1 + nrm((D,), 0.02),
        'w_ffn_in': nrm((DEPTH, 2, D, 2 * D_FF), D ** -0.5),
        'w_ffn_out': nrm((DEPTH, 2, D_FF, D), D_FF ** -0.5),
        'mla_w_dq': nrm((N_MLA, D, Q_LORA), D ** -0.5),
        'mla_q_norm': 1 + nrm((N_MLA, Q_LORA), 0.02),
        'mla_w_uq': nrm((N_MLA, Q_LORA, H * (QK_NOPE + QK_ROPE)), Q_LORA ** -0.5),
        'mla_w_dkv': nrm((N_MLA, D, KV_LORA + QK_ROPE), D ** -0.5),
        'mla_kv_norm': 1 + nrm((N_MLA, KV_LORA), 0.02),
        'mla_w_ukv': nrm((N_MLA, KV_LORA, H * (QK_NOPE + V_DIM)), KV_LORA ** -0.5),
        'mla_w_o': nrm((N_MLA, H * V_DIM, D), (H * V_DIM) ** -0.5),
        'rwkv_mu': uni((N_RWKV, 4, D), 0.0, 1.0),
        'rwkv_mu_dir': uni((N_RWKV, 2, 2, D), 0.0, 1.0),
        'rwkv_w_r': nrm((N_RWKV, D, D), D ** -0.5),
        'rwkv_w_k': nrm((N_RWKV, D, D), D ** -0.5),
        'rwkv_w_v': nrm((N_RWKV, D, D), D ** -0.5),
        'rwkv_w0': uni((N_RWKV, 2, D), -5.0, 1.0),
        'rwkv_w1': nrm((N_RWKV, 2, D, DECAY_LORA), D ** -0.5),
        'rwkv_w2': nrm((N_RWKV, 2, DECAY_LORA, D), 0.5 * DECAY_LORA ** -0.5),
        'rwkv_a0': nrm((N_RWKV, 2, D), 0.5),
        'rwkv_a1': nrm((N_RWKV, 2, D, A_LORA), D ** -0.5),
        'rwkv_a2': nrm((N_RWKV, 2, A_LORA, D), 0.5 * A_LORA ** -0.5),
        'rwkv_g1': nrm((N_RWKV, D, G_LORA), D ** -0.5),
        'rwkv_g2': nrm((N_RWKV, G_LORA, D), G_LORA ** -0.5),
        'rwkv_k_k': 0.85 + nrm((N_RWKV, D), 0.05),
        'rwkv_k_a': 1 + nrm((N_RWKV, D), 0.05),
        'rwkv_r_k': nrm((N_RWKV, RH, N), 0.1),
        'rwkv_ln_w': 1 + nrm((N_RWKV, D), 0.02),
        'rwkv_ln_b': nrm((N_RWKV, D), 0.02),
        'rwkv_w_o': nrm((N_RWKV, D, D), D ** -0.5),
    }


def reference(x_prompt, x_sample, cache_ckv, cache_krope, state_wkv_fwd, state_wkv_bwd, c, c_ctx,
              w_ada, b_ada, norm_sub, norm_final, w_ffn_in, w_ffn_out,
              mla_w_dq, mla_q_norm, mla_w_uq, mla_w_dkv, mla_kv_norm, mla_w_ukv, mla_w_o,
              rwkv_mu, rwkv_mu_dir, rwkv_w_r, rwkv_w_k, rwkv_w_v, rwkv_w0, rwkv_w1, rwkv_w2,
              rwkv_a0, rwkv_a1, rwkv_a2, rwkv_g1, rwkv_g2, rwkv_k_k, rwkv_k_a, rwkv_r_k,
              rwkv_ln_w, rwkv_ln_b, rwkv_w_o):
    p = dict(w_ada=w_ada, b_ada=b_ada, norm_sub=norm_sub, norm_final=norm_final,
             w_ffn_in=w_ffn_in, w_ffn_out=w_ffn_out,
             mla_w_dq=mla_w_dq, mla_q_norm=mla_q_norm, mla_w_uq=mla_w_uq, mla_w_dkv=mla_w_dkv,
             mla_kv_norm=mla_kv_norm, mla_w_ukv=mla_w_ukv, mla_w_o=mla_w_o,
             rwkv_mu=rwkv_mu, rwkv_mu_dir=rwkv_mu_dir, rwkv_w_r=rwkv_w_r, rwkv_w_k=rwkv_w_k,
             rwkv_w_v=rwkv_w_v, rwkv_w0=rwkv_w0, rwkv_w1=rwkv_w1, rwkv_w2=rwkv_w2,
             rwkv_a0=rwkv_a0, rwkv_a1=rwkv_a1, rwkv_a2=rwkv_a2, rwkv_g1=rwkv_g1, rwkv_g2=rwkv_g2,
             rwkv_k_k=rwkv_k_k, rwkv_k_a=rwkv_k_a, rwkv_r_k=rwkv_r_k,
             rwkv_ln_w=rwkv_ln_w, rwkv_ln_b=rwkv_ln_b, rwkv_w_o=rwkv_w_o)
    y_prompt, new_ckv, new_krope, new_sf, new_sb = _context_pass(x_prompt, c_ctx, p)
    y_sample = _latent_pass(x_sample, c, cache_ckv, cache_krope, state_wkv_fwd, state_wkv_bwd, p)
    return (y_prompt, y_sample, new_ckv, new_krope, new_sf, new_sb)
```

```cpp
#include <hip/hip_runtime.h>
#include <cstdio>
#include <cstdint>
namespace pg8 {
#define PG8_LAS __attribute__((address_space(3)))
typedef unsigned short bf16_t;
typedef short bf16x8 __attribute__((ext_vector_type(8)));
typedef float f32x4 __attribute__((ext_vector_type(4)));
typedef unsigned u32x4 __attribute__((ext_vector_type(4)));
constexpr int BM = 256, BK = 64, HALF = 128, HTB = HALF * BK * 2  , STAGE_BYTES = 8 * HTB, NXCD = 8, WGM = 8;

__host__ __device__ __forceinline__ int lds_byte(int r, int c) { const int st = (r >> 4) * 2 + (c >> 5), rr = r & 15, cc = c & 31, ob = rr * 64 + cc * 2; return st * 1024 + (ob ^ (((ob >> 9) & 1) << 5)); }
__host__ __device__ __forceinline__ void stage_rc(int b, int& R, int& C) { const int st = b / 1024, sb = b % 1024, swz = sb ^ (((sb >> 9) & 1) << 5); R = (st >> 1) * 16 + swz / 64; C = (st & 1) * 32 + (swz % 64) / 2; }
__host__ __device__ __forceinline__ int perm32(int rho) { const int n = rho >> 4, i = rho & 15; return 8 * (i >> 2) + 4 * n + (i & 3); }

struct Unit { int pm, pn, g; };

__device__ __forceinline__ void tile_of(int L, int nM, int nN, int& pm, int& pn) {
    const int nwg = nM * nN; int wgid = L; { const int q = nwg / NXCD, r = nwg % NXCD, xcd = wgid % NXCD, off = wgid / NXCD; wgid = (xcd < r ? xcd * (q + 1) : r * (q + 1) + (xcd - r) * q) + off; }
    const int nig = WGM * nN, gid = wgid / nig, fm = gid * WGM, gsz = (nM - fm) < WGM ? (nM - fm) : WGM;
    pm = fm + ((wgid % nig) % gsz); pn = (wgid % nig) / gsz;
}
__device__ __forceinline__ int opaque_v(int x) { asm volatile("" : "+v"(x)); return x; }
__device__ __forceinline__ int opaque_s(int x) { asm volatile("" : "+v"(x)); return __builtin_amdgcn_readfirstlane(x); }
__device__ __forceinline__ int lane_id_v() { int l; asm volatile("v_mbcnt_lo_u32_b32 %0, -1, 0\n\tv_mbcnt_hi_u32_b32 %0, -1, %0" : "=v"(l)); return l; }
template <class Epi, class Sched, bool ALIGN_EPI = false, bool SP2 = false, int MB = 4>
__device__ __forceinline__ void gemm_phase(PG8_LAS unsigned char* lds, const int K, const Sched& S, const Epi& E, const int tid_in) {
    const int tid = opaque_v(tid_in), wid = __builtin_amdgcn_readfirstlane(tid >> 6), lane = tid & 63, wr = wid >> 2, wc = wid & 3, fr = lane & 15, fq = lane >> 4;
    const int nt = K / BK;
    unsigned voffA[2], voffB[2];
#pragma unroll
    for (int i = 0; i < 2; ++i) { int R, C; stage_rc(tid * 16 + i * 8192, R, C); const int Rb = Epi::PERM ? ((R & ~31) + perm32(R & 31)) : R;
        const int mR = (R >> 4) & 3, Ra = MB == 4 ? R : (R >> 6) * (16 * MB) + (mR < MB ? mR : MB - 1) * 16 + (R & 15);
        voffA[i] = (unsigned)(Ra * K + C) * 2u; voffB[i] = (unsigned)(Rb * K + C) * 2u; }
    const size_t kstep = (size_t)(BK * 2);
    const size_t hstep = (size_t)HALF * K * 2;
    const size_t hstepA = (size_t)(32 * MB) * K * 2;
    const unsigned ldsw = (unsigned)wid * 1024u;
    const int aoff = lds_byte(wr * 64 + fr, fq * 8), boff = lds_byte(wc * 32 + fr, fq * 8);
#define PG8_SA(b, h) (((b) * 2 + (h)) * HTB)
#define PG8_SB(b, h) ((4 + (b) * 2 + (h)) * HTB)
#define PG8_STAGE(bufoff, gbase, voff) do { _Pragma("unroll") for (int _i = 0; _i < 2; ++_i) \
        __builtin_amdgcn_global_load_lds((const unsigned*)((const char*)(gbase) + (voff)[_i]), (PG8_LAS unsigned*)(lds + (bufoff) + ldsw + _i * 8192), 16, 0, 0); } while (0)
#define PG8_LDA(dst, b, h) do { _Pragma("unroll") for (int m = 0; m < MB; ++m) _Pragma("unroll") for (int k = 0; k < 2; ++k) dst[m][k] = *(const PG8_LAS bf16x8*)(lds + PG8_SA(b, h) + aoff + m * 2048 + k * 1024); } while (0)
#define PG8_LDB(dst, b, h) do { _Pragma("unroll") for (int n = 0; n < 2; ++n) _Pragma("unroll") for (int k = 0; k < 2; ++k) dst[n][k] = *(const PG8_LAS bf16x8*)(lds + PG8_SB(b, h) + boff + n * 2048 + k * 1024); } while (0)
#define PG8_MMA(ai, bj, At, Bt) do { __builtin_amdgcn_s_setprio(1); _Pragma("unroll") for (int m = 0; m < MB; ++m) _Pragma("unroll") for (int n = 0; n < 2; ++n) _Pragma("unroll") for (int k = 0; k < 2; ++k) \
        acc[ai][bj][m][n] = __builtin_amdgcn_mfma_f32_16x16x32_bf16(Bt[n][k], At[m][k], acc[ai][bj][m][n], 0, 0, 0); __builtin_amdgcn_s_setprio(0); } while (0)
#define PG8_WAIT_V(n) asm volatile("s_waitcnt vmcnt(" #n ")" ::: "memory")
#define PG8_WAIT_L(n) asm volatile("s_waitcnt lgkmcnt(" #n ")" ::: "memory")
#define PG8_BAR __builtin_amdgcn_s_barrier()
#define PG8_SCHED __builtin_amdgcn_sched_barrier(0)
    Unit cur, nxt; int ui = 0;
    if (!S.next(0, cur)) return;
    f32x4 acc[2][2][MB][2];
#pragma unroll
    for (int a = 0; a < 2; ++a)
#pragma unroll
        for (int b = 0; b < 2; ++b)
#pragma unroll
            for (int m = 0; m < MB; ++m)
#pragma unroll
                for (int n = 0; n < 2; ++n) acc[a][b][m][n] = (f32x4){0.f, 0.f, 0.f, 0.f};
    bf16x8 At[MB][2], B0[2][2], B1[2][2];
    const char* cA = S.a_ptr(cur); const char* cB = S.b_ptr(cur);
    S.a_ready(cur);
    if constexpr (SP2) {
        PG8_STAGE(PG8_SB(0, 0), cB, voffB); PG8_STAGE(PG8_SB(0, 1), cB + hstep, voffB); PG8_STAGE(PG8_SA(0, 0), cA, voffA); PG8_STAGE(PG8_SA(0, 1), cA + hstepA, voffA);
        if (wr == 1) PG8_BAR;
        PG8_WAIT_V(2); PG8_BAR;
        PG8_STAGE(PG8_SB(1, 0), cB + kstep, voffB); PG8_STAGE(PG8_SA(1, 0), cA + kstep, voffA); PG8_STAGE(PG8_SB(1, 1), cB + hstep + kstep, voffB);
        PG8_WAIT_V(6); PG8_BAR;
    } else {
        PG8_STAGE(PG8_SB(0, 0), cB, voffB); PG8_STAGE(PG8_SA(0, 0), cA, voffA); PG8_STAGE(PG8_SB(0, 1), cB + hstep, voffB); PG8_STAGE(PG8_SA(0, 1), cA + hstepA, voffA);
        if (wr == 1) PG8_BAR;
        PG8_WAIT_V(4); PG8_BAR;
        PG8_STAGE(PG8_SB(1, 0), cB + kstep, voffB); PG8_STAGE(PG8_SA(1, 0), cA + kstep, voffA); PG8_STAGE(PG8_SB(1, 1), cB + hstep + kstep, voffB);
        PG8_WAIT_V(6); PG8_BAR;
    }
    for (;;) {
        const bool has_next = S.next(ui + 1, nxt);
        const char* nA = has_next ? S.a_ptr(nxt) : cA; const char* nB = has_next ? S.b_ptr(nxt) : cB;
        for (int t = 0; t < nt; t += 2) {
            const bool last = (t == nt - 2);
            const char* a1 = cA + (size_t)(t + 1) * kstep;
            const char* a2 = last ? nA : cA + (size_t)(t + 2) * kstep; const char* b2 = last ? nB : cB + (size_t)(t + 2) * kstep;
            const char* a3 = a2 + kstep; const char* b3 = b2 + kstep;
            if (last && has_next) S.a_ready(nxt);
            if constexpr (SP2) {
            PG8_LDB(B0, 0, 0); PG8_LDB(B1, 0, 1); PG8_SCHED; PG8_LDA(At, 0, 0); PG8_STAGE(PG8_SA(1, 1), a1 + hstepA, voffA);
            PG8_WAIT_V(8); PG8_WAIT_L(0); PG8_BAR; PG8_MMA(0, 0, At, B0); PG8_MMA(0, 1, At, B1); PG8_BAR; PG8_SCHED;
            PG8_LDA(At, 0, 1); PG8_STAGE(PG8_SB(0, 0), b2, voffB); PG8_STAGE(PG8_SB(0, 1), b2 + hstep, voffB); PG8_STAGE(PG8_SA(0, 0), a2, voffA);
            PG8_WAIT_V(8); PG8_WAIT_L(0); PG8_BAR; PG8_MMA(1, 0, At, B0); PG8_MMA(1, 1, At, B1); PG8_BAR; PG8_SCHED;
            PG8_LDB(B0, 1, 0); PG8_LDB(B1, 1, 1); PG8_SCHED; PG8_LDA(At, 1, 0); PG8_STAGE(PG8_SA(0, 1), a2 + hstepA, voffA);
            PG8_WAIT_V(8); PG8_WAIT_L(0); PG8_BAR; PG8_MMA(0, 0, At, B0); PG8_MMA(0, 1, At, B1); PG8_BAR; PG8_SCHED;
            PG8_LDA(At, 1, 1); PG8_STAGE(PG8_SB(1, 0), b3, voffB); PG8_STAGE(PG8_SB(1, 1), b3 + hstep, voffB); PG8_STAGE(PG8_SA(1, 0), a3, voffA);
            PG8_WAIT_V(8); PG8_WAIT_L(0); PG8_BAR; PG8_MMA(1, 0, At, B0); PG8_MMA(1, 1, At, B1); PG8_BAR; PG8_SCHED;
            } else {
            PG8_LDB(B0, 0, 0); PG8_SCHED; PG8_LDA(At, 0, 0); PG8_STAGE(PG8_SA(1, 1), a1 + hstepA, voffA);
            PG8_WAIT_L(8); PG8_BAR; PG8_WAIT_L(0); PG8_MMA(0, 0, At, B0); PG8_BAR; PG8_SCHED;
            PG8_LDB(B1, 0, 1); PG8_STAGE(PG8_SB(0, 0), b2, voffB);
            PG8_BAR; PG8_WAIT_L(0); PG8_MMA(0, 1, At, B1); PG8_BAR;
            PG8_LDA(At, 0, 1); PG8_STAGE(PG8_SA(0, 0), a2, voffA);
            PG8_BAR; PG8_WAIT_L(0); PG8_MMA(1, 0, At, B0); PG8_BAR; PG8_SCHED;
            PG8_STAGE(PG8_SB(0, 1), b2 + hstep, voffB);
            PG8_WAIT_V(6); PG8_BAR; PG8_MMA(1, 1, At, B1); PG8_BAR;
            PG8_LDB(B0, 1, 0); PG8_SCHED; PG8_LDA(At, 1, 0); PG8_STAGE(PG8_SA(0, 1), a2 + hstepA, voffA);
            PG8_WAIT_L(8); PG8_BAR; PG8_WAIT_L(0); PG8_MMA(0, 0, At, B0); PG8_BAR; PG8_SCHED;
            PG8_LDB(B1, 1, 1); PG8_STAGE(PG8_SB(1, 0), b3, voffB);
            PG8_BAR; PG8_WAIT_L(0); PG8_MMA(0, 1, At, B1); PG8_BAR;
            PG8_LDA(At, 1, 1); PG8_STAGE(PG8_SA(1, 0), a3, voffA);
            PG8_BAR; PG8_WAIT_L(0); PG8_MMA(1, 0, At, B0); PG8_BAR; PG8_SCHED;
            PG8_STAGE(PG8_SB(1, 1), b3 + hstep, voffB);
            PG8_WAIT_V(6); PG8_BAR; PG8_MMA(1, 1, At, B1); PG8_BAR;
            }
        }
        if constexpr (ALIGN_EPI) { if (wr == 0) PG8_BAR; }
        if constexpr (!Epi::AFTER_DRAIN) { E(acc, cur, wr, wc, fr, fq); S.done(cur); }
        if (!has_next) break;
#pragma unroll
        for (int a = 0; a < 2; ++a)
#pragma unroll
            for (int b = 0; b < 2; ++b)
#pragma unroll
                for (int m = 0; m < MB; ++m)
#pragma unroll
                    for (int n = 0; n < 2; ++n) acc[a][b][m][n] = (f32x4){0.f, 0.f, 0.f, 0.f};
        cur = nxt; cA = nA; cB = nB; ++ui;
        if constexpr (ALIGN_EPI) { if (wr == 1) PG8_BAR; }
    }
    PG8_WAIT_V(0);
    if constexpr (!ALIGN_EPI) { if (wr == 0) PG8_BAR; }
    PG8_BAR;
    if constexpr (Epi::AFTER_DRAIN) { E.fused(acc, cur, wr, wc, fr, fq, lds, wid, lane); S.done(cur); }
#undef PG8_SA
#undef PG8_SB
#undef PG8_STAGE
#undef PG8_LDA
#undef PG8_LDB
#undef PG8_MMA
#undef PG8_WAIT_V
#undef PG8_WAIT_L
#undef PG8_BAR
#undef PG8_SCHED
}

struct SchedBase { __device__ __forceinline__ void a_ready(const Unit&) const {} __device__ __forceinline__ void done(const Unit&) const {} };
struct Sched1 : SchedBase {
    const char* A; const char* B; int nM, nN, G, c; size_t tstep, tstepB;
    __device__ __forceinline__ bool next(int i, Unit& u) const { const long L = (long)i * G + c; if (L >= (long)nM * nN) return false; tile_of((int)L, nM, nN, u.pm, u.pn); u.g = 0; return true; }
    __device__ __forceinline__ const char* a_ptr(const Unit& u) const { return A + (size_t)u.pm * tstep; }
    __device__ __forceinline__ const char* b_ptr(const Unit& u) const { return B + (size_t)u.pn * tstepB; }
};
struct SchedFa : SchedBase {
    const char* A; const char* B; int G, c; size_t tstep;
    __device__ __forceinline__ bool next(int i, Unit& u) const { const long L = (long)i * G + c; if (L >= 2048) return false; if (L < 2024) tile_of((int)L, 46, 44, u.pm, u.pn); else { u.pm = 46; u.pn = (int)L - 2024; } u.g = 0; return true; }
    __device__ __forceinline__ const char* a_ptr(const Unit& u) const { return A + (size_t)u.pm * tstep; }
    __device__ __forceinline__ const char* b_ptr(const Unit& u) const { return B + (size_t)u.pn * tstep; }
};
struct SchedFb : SchedBase {
    const char* A; const char* B; int G, c; size_t tstep;
    __device__ __forceinline__ bool next(int i, Unit& u) const { const long L0 = (long)i * G + c; if (L0 >= 256) return false;
        const int L = ((int)L0 & 7) * 32 + ((int)L0 >> 3);
        if (L < 80) { u.pn = 24 + (L >> 2); u.pm = 46 * 4 + (L & 3); } else { const int L1 = L - 80; u.pn = L1 >> 2; u.pm = 47 * 4 + (L1 & 3); } u.g = 0; return true; }
    __device__ __forceinline__ const char* a_ptr(const Unit& u) const { return A + (size_t)u.pm * (tstep >> 2); }
    __device__ __forceinline__ const char* b_ptr(const Unit& u) const { return B + (size_t)u.pn * tstep; }
};
struct SchedR2 : SchedBase {
    const char* A; const char* B; int nM, G, c; size_t tstep, astride;
    __device__ __forceinline__ bool next(int i, Unit& u) const { const long L = (long)i * G + c; if (L >= (long)nM * 29) return false; tile_of((int)L, nM, 29, u.pm, u.pn); u.g = u.pn < 24 ? (u.pn >> 3) : (u.pn - 21); return true; }
    __device__ __forceinline__ const char* a_ptr(const Unit& u) const { return A + (size_t)u.g * astride + (size_t)u.pm * tstep; }
    __device__ __forceinline__ const char* b_ptr(const Unit& u) const { return B + (size_t)u.pn * tstep; }
};
struct SchedR3 : SchedBase {
    const char* A; const char* B; int nM, G, c; size_t tstep, astride;
    __device__ __forceinline__ bool next(int i, Unit& u) const { const long L = (long)i * G + c; if (L >= (long)nM * 40) return false; tile_of((int)L, nM, 40, u.pm, u.pn); u.g = u.pn >> 3; return true; }
    __device__ __forceinline__ const char* a_ptr(const Unit& u) const { return A + (size_t)u.g * astride + (size_t)u.pm * tstep; }
    __device__ __forceinline__ const char* b_ptr(const Unit& u) const { return B + (size_t)u.pn * tstep; }
};
struct SchedM3 : SchedBase {
    const char* A0; const char* B0; const char* A1; const char* B1; int nM0, nN0, nM1, nN1, G, c; size_t tstep;
    __device__ __forceinline__ bool next(int i, Unit& u) const { const long L = (long)i * G + c; const int n0 = nM0 * nN0; if (L >= (long)n0 + nM1 * nN1) return false;
        if (L < n0) { tile_of((int)L, nM0, nN0, u.pm, u.pn); u.g = 0; } else { tile_of((int)L - n0, nM1, nN1, u.pm, u.pn); u.g = 1; } return true; }
    __device__ __forceinline__ const char* a_ptr(const Unit& u) const { return (u.g ? A1 : A0) + (size_t)u.pm * tstep; }
    __device__ __forceinline__ const char* b_ptr(const Unit& u) const { return (u.g ? B1 : B0) + (size_t)u.pn * tstep; }
};

__device__ __forceinline__ unsigned cvt_pk_bf16(float lo, float hi) { unsigned r; asm volatile("s_nop 0\n\tv_cvt_pk_bf16_f32 %0, %1, %2" : "=v"(r) : "v"(lo), "v"(hi)); return r; }
typedef unsigned u32x2 __attribute__((ext_vector_type(2)));
__device__ __forceinline__ float fast_sigmoid(float x) { return __builtin_amdgcn_rcpf(1.0f + __builtin_amdgcn_exp2f(-1.44269504f * x)); }
__device__ __forceinline__ float fast_tanh(float x) { return 1.0f - 2.0f * __builtin_amdgcn_rcpf(1.0f + __builtin_amdgcn_exp2f(2.88539008f * x)); }

struct EpiF32 {
    static constexpr bool PERM = false, AFTER_DRAIN = false;
    float* C; int ldc;
    __device__ __forceinline__ void operator()(const f32x4 (&acc)[2][2][4][2], const Unit& u, int wr, int wc, int fr, int fq) const {
        const int row0 = u.pm * BM + wr * 64 + fr, col0 = u.pn * BM + wc * 32 + 4 * fq;
#pragma unroll
        for (int ai = 0; ai < 2; ++ai)
#pragma unroll
            for (int m = 0; m < 4; ++m) { float* rowp = C + (size_t)(row0 + ai * HALF + m * 16) * ldc + col0;
#pragma unroll
                for (int bj = 0; bj < 2; ++bj)
#pragma unroll
                    for (int n = 0; n < 2; ++n) *(f32x4*)(rowp + bj * HALF + n * 16) = acc[ai][bj][m][n]; }
    }
};
template <int MB> struct EpiSwigluT {
    static constexpr bool PERM = true, AFTER_DRAIN = false;
    bf16_t* U;
    __device__ __forceinline__ void operator()(const f32x4 (&acc)[2][2][MB][2], const Unit& u, int wr, int wc, int fr, int fq) const {
        const int row0 = u.pm * (64 * MB) + wr * (16 * MB) + fr, col0 = u.pn * HALF + wc * 32 + 8 * fq;
#pragma unroll
        for (int ai = 0; ai < 2; ++ai)
#pragma unroll
            for (int m = 0; m < MB; ++m) { bf16_t* rowp = U + (size_t)(row0 + ai * (32 * MB) + m * 16) * 5632 + col0;
                u32x4 w;
#pragma unroll
                for (int n = 0; n < 2; ++n) { const f32x4 g = acc[ai][0][m][n], v = acc[ai][1][m][n]; f32x4 o;
#pragma unroll
                    for (int e = 0; e < 4; ++e) o[e] = g[e] * fast_sigmoid(g[e]) * v[e];
                    w[2 * n] = cvt_pk_bf16(o[0], o[1]); w[2 * n + 1] = cvt_pk_bf16(o[2], o[3]); }
                *(u32x4*)rowp = w; }
    }
};
__device__ __forceinline__ float bf_lo(unsigned w) { return __builtin_bit_cast(float, w << 16); }
__device__ __forceinline__ float bf_hi(unsigned w) { return __builtin_bit_cast(float, w & 0xffff0000u); }
template <int MB> struct EpiResidT {
    static constexpr bool PERM = true, AFTER_DRAIN = false;
    bf16_t* X; const float* mod; float sc;
    __device__ __forceinline__ void operator()(const f32x4 (&acc)[2][2][MB][2], const Unit& u, int wr, int wc, int fr, int fq) const {
        const int col0 = u.pn * BM + wc * 32 + 8 * fq;
#pragma unroll
        for (int ai = 0; ai < 2; ++ai)
#pragma unroll
            for (int m = 0; m < MB; ++m) { const int rb = u.pm * (64 * MB) + ai * (32 * MB) + wr * (16 * MB) + m * 16;
                const int grp = rb < 8192 ? 0 : 1 + ((rb - 8192) >> 10);
                const float* gp = mod + (size_t)grp * (9 * 2048) + col0;
                bf16_t* rowp = X + (size_t)(rb + fr) * 2048 + col0;
#pragma unroll
                for (int bj = 0; bj < 2; ++bj) { u32x4* p = (u32x4*)(rowp + bj * HALF); const u32x4 xv = *p;
                    const f32x4 g0 = *(const f32x4*)(gp + bj * HALF) * sc, g1 = *(const f32x4*)(gp + bj * HALF + 4) * sc;
                    const f32x4 a0 = acc[ai][bj][m][0], a1 = acc[ai][bj][m][1];
                    u32x4 w;
                    w.x = cvt_pk_bf16(bf_lo(xv.x) + g0[0] * a0[0], bf_hi(xv.x) + g0[1] * a0[1]); w.y = cvt_pk_bf16(bf_lo(xv.y) + g0[2] * a0[2], bf_hi(xv.y) + g0[3] * a0[3]);
                    w.z = cvt_pk_bf16(bf_lo(xv.z) + g1[0] * a1[0], bf_hi(xv.z) + g1[1] * a1[1]); w.w = cvt_pk_bf16(bf_lo(xv.w) + g1[2] * a1[2], bf_hi(xv.w) + g1[3] * a1[3]);
                    *p = w; } }
    }
};
struct EpiM3 {
    static constexpr bool PERM = true, AFTER_DRAIN = false;
    bf16_t* Q; bf16_t* KV;
    __device__ __forceinline__ void operator()(const f32x4 (&acc)[2][2][4][2], const Unit& u, int wr, int wc, int fr, int fq) const {
        const int row0 = u.pm * BM + wr * 64 + fr, col0 = u.pn * BM + wc * 32 + 8 * fq;
        bf16_t* base = u.g ? KV : Q; const int ldc = u.g ? 4096 : 3072;
#pragma unroll
        for (int ai = 0; ai < 2; ++ai)
#pragma unroll
            for (int m = 0; m < 4; ++m) { bf16_t* rowp = base + (size_t)(row0 + ai * HALF + m * 16) * ldc + col0;
#pragma unroll
                for (int bj = 0; bj < 2; ++bj) { const f32x4 o0 = acc[ai][bj][m][0], o1 = acc[ai][bj][m][1];
                    u32x4 w; w.x = cvt_pk_bf16(o0[0], o0[1]); w.y = cvt_pk_bf16(o0[2], o0[3]); w.z = cvt_pk_bf16(o1[0], o1[1]); w.w = cvt_pk_bf16(o1[2], o1[3]); *(u32x4*)(rowp + bj * HALF) = w; } }
    }
};
struct EpiR2 {
    static constexpr bool PERM = true, AFTER_DRAIN = false;
    bf16_t* RKV; size_t rkv_stride; bf16_t* T1; size_t t1_stride; size_t rows_total;
    __device__ __forceinline__ void operator()(const f32x4 (&acc)[2][2][4][2], const Unit& u, int wr, int wc, int fr, int fq) const {
        const int row0 = u.pm * BM + wr * 64 + fr;
        if (u.g < 3) {
            bf16_t* base = RKV + (size_t)u.g * rkv_stride;
            const int hq = (u.pn & 7) * 4 + (wc >> 1), cin = (wc & 1) * 32 + 8 * fq;
            const unsigned voff = (unsigned)(row0 * 64 + cin);
#pragma unroll
            for (int bj = 0; bj < 2; ++bj) { bf16_t* hb = base + (size_t)(hq + bj * 2) * rows_total * 64;
#pragma unroll
                for (int ai = 0; ai < 2; ++ai)
#pragma unroll
                    for (int m = 0; m < 4; ++m) { const f32x4 o0 = acc[ai][bj][m][0], o1 = acc[ai][bj][m][1];
                        u32x4 w; w.x = cvt_pk_bf16(o0[0], o0[1]); w.y = cvt_pk_bf16(o0[2], o0[3]); w.z = cvt_pk_bf16(o1[0], o1[1]); w.w = cvt_pk_bf16(o1[2], o1[3]);
                        *(u32x4*)(hb + (voff + (unsigned)((ai * HALF + m * 16) * 64))) = w; } }
        } else {
            const int slot = u.g - 3; bf16_t* base = T1 + (size_t)slot * t1_stride + wc * 32 + 8 * fq;
            const int act = slot == 0 ? 1 : ((slot & 1) ? 2 : 0);
#pragma unroll
            for (int ai = 0; ai < 2; ++ai)
#pragma unroll
                for (int m = 0; m < 4; ++m) { bf16_t* rowp = base + (size_t)(row0 + ai * HALF + m * 16) * 256;
#pragma unroll
                    for (int bj = 0; bj < 2; ++bj) { u32x4 w;
#pragma unroll
                        for (int n = 0; n < 2; ++n) { f32x4 o = acc[ai][bj][m][n];
                            if (act == 1) { _Pragma("unroll") for (int e = 0; e < 4; ++e) o[e] = fast_sigmoid(o[e]); }
                            else if (act == 2) { _Pragma("unroll") for (int e = 0; e < 4; ++e) o[e] = fast_tanh(o[e]); }
                            w[2 * n] = cvt_pk_bf16(o[0], o[1]); w[2 * n + 1] = cvt_pk_bf16(o[2], o[3]); }
                        *(u32x4*)(rowp + bj * HALF) = w; } }
        }
    }
};
__device__ __forceinline__ unsigned cvt_pk_unorm16(float lo, float hi) { unsigned r; asm volatile("s_nop 0\n\tv_cvt_pknorm_u16_f32 %0, %1, %2" : "=v"(r) : "v"(lo), "v"(hi)); return r; }
struct EpiR3 {
    static constexpr bool PERM = true, AFTER_DRAIN = false;
    bf16_t* G; bf16_t* DEC; bf16_t* AA; size_t dstride; const float* w0; const float* a0; size_t rows_total;
    template <int KIND> __device__ __forceinline__ void run(const f32x4 (&acc)[2][2][4][2], bf16_t* base, const float* bp, int row0, int hq, int cin) const {
#pragma unroll
        for (int bj = 0; bj < 2; ++bj) { f32x4 bv0 = (f32x4){0.f, 0.f, 0.f, 0.f}, bv1 = bv0; if (KIND != 0) { bv0 = *(const f32x4*)(bp + bj * HALF); bv1 = *(const f32x4*)(bp + bj * HALF + 4); }
            bf16_t* hb = KIND == 0 ? base : base + (size_t)(hq + bj * 2) * rows_total * 64;
            const unsigned voff = KIND == 0 ? (unsigned)(row0 * 2048 + cin + bj * HALF) : (unsigned)(row0 * 64 + cin);
#pragma unroll
            for (int ai = 0; ai < 2; ++ai)
#pragma unroll
                for (int m = 0; m < 4; ++m) { f32x4 o0 = acc[ai][bj][m][0] + bv0, o1 = acc[ai][bj][m][1] + bv1; const int rr_ = ai * HALF + m * 16; u32x4 w;
                    if (KIND == 1) { _Pragma("unroll") for (int e = 0; e < 4; ++e) { o0[e] = 2.0f * __builtin_amdgcn_exp2f((-0.60653066f * 1.44269504f) * fast_sigmoid(o0[e])) - 1.0f; o1[e] = 2.0f * __builtin_amdgcn_exp2f((-0.60653066f * 1.44269504f) * fast_sigmoid(o1[e])) - 1.0f; } }
                    if (KIND == 2) { _Pragma("unroll") for (int e = 0; e < 4; ++e) { o0[e] = fast_sigmoid(o0[e]); o1[e] = fast_sigmoid(o1[e]); } }
                    if (KIND == 0) { w.x = cvt_pk_bf16(o0[0], o0[1]); w.y = cvt_pk_bf16(o0[2], o0[3]); w.z = cvt_pk_bf16(o1[0], o1[1]); w.w = cvt_pk_bf16(o1[2], o1[3]); }
                    else { w.x = cvt_pk_unorm16(o0[0], o0[1]); w.y = cvt_pk_unorm16(o0[2], o0[3]); w.z = cvt_pk_unorm16(o1[0], o1[1]); w.w = cvt_pk_unorm16(o1[2], o1[3]); }
                    *(u32x4*)(hb + (voff + (unsigned)(rr_ * (KIND == 0 ? 2048 : 64)))) = w; } }
    }
    __device__ __forceinline__ void operator()(const f32x4 (&acc)[2][2][4][2], const Unit& u, int wr, int wc, int fr, int fq) const {
        const int lane_ = lane_id_v(), fq8 = 8 * (lane_ >> 4);
        const int row0 = u.pm * BM + wr * 64 + (lane_ & 15), col0 = (u.pn & 7) * BM + wc * 32 + fq8;
        const int hq = (u.pn & 7) * 4 + (wc >> 1), cin = (wc & 1) * 32 + fq8;
        const int slot = u.g, dir = slot == 0 ? 0 : ((slot - 1) >> 1);
        if (slot == 0) run<0>(acc, G, w0, row0, hq, col0);
        else if (slot & 1) run<1>(acc, DEC + (size_t)dir * dstride, w0 + dir * 2048 + col0, row0, hq, cin);
        else run<2>(acc, AA + (size_t)dir * dstride, a0 + dir * 2048 + col0, row0, hq, cin);
    }
};
}
#define LAS __attribute__((address_space(3)))
#define XB_TMO      128
#define XB_XCNT(j)  (256  + 64 * (j))
#define XB_XSUB(j)  (1280 + 64 * (j))
#define XB_XGEN(j)  (2304 + 64 * (j))
#define XB_TOP      3328
#define XB_TOPGEN   3392
#define XCD_BAR_WORDS 3456
#define XB_SPIN_CAP (1u << 18)


__device__ __forceinline__ unsigned xb_ld(unsigned* p)              { return __hip_atomic_load(p, __ATOMIC_RELAXED, __HIP_MEMORY_SCOPE_AGENT); }
__device__ __forceinline__ unsigned xb_add(unsigned* p, unsigned v) { return __hip_atomic_fetch_add(p, v, __ATOMIC_RELAXED, __HIP_MEMORY_SCOPE_AGENT); }
__device__ __forceinline__ unsigned xb_xcc_id() { return (unsigned)__builtin_amdgcn_s_getreg((3 << 11) | 20) & 0xFu; }
#define XB_SPIN(cond, bar) do { unsigned _sp = 0; while (cond) { __builtin_amdgcn_s_sleep(1); \
    if ((++_sp & 255u) == 0u) { if (xb_ld(&(bar)[XB_TMO])) break; if (_sp > XB_SPIN_CAP) { atomicAdd(&(bar)[XB_TMO], 1u); break; } } } } while (0)

struct XcdBarrier {
    unsigned* bar; unsigned x; unsigned lead;
    volatile LAS unsigned* st;
};

__device__ __forceinline__ XcdBarrier xcd_barrier_post(unsigned* bar, volatile LAS unsigned* st) {
    XcdBarrier b; b.bar = bar; b.x = xb_xcc_id(); b.st = st; b.lead = threadIdx.x == 0 ? 1u : 0u;
    if (threadIdx.x == 0) (void)xb_add(&bar[XB_XCNT(b.x)], 1u);
    return b;
}
__device__ __forceinline__ void xcd_barrier_complete(unsigned* bar, unsigned x, unsigned& nloc, unsigned& nx) {
    const unsigned G = gridDim.x * gridDim.y * gridDim.z;
    unsigned sum, cnt, mine, sp = 0u;
    for (;;) {
        sum = 0u; cnt = 0u; mine = 0u;
#pragma unroll
        for (unsigned j = 0; j < 16; ++j) { const unsigned c = xb_ld(&bar[XB_XCNT(j)]); sum += c; cnt += (c > 0u) ? 1u : 0u; mine = (j == x) ? c : mine; }
        if (sum == G) break;
        __builtin_amdgcn_s_sleep(1);
        if ((++sp & 255u) == 0u) { if (xb_ld(&bar[XB_TMO])) break; if (sp > XB_SPIN_CAP) { atomicAdd(&bar[XB_TMO], 1u); break; } }
    }
    nloc = mine > 0u ? mine : 1u; nx = cnt > 0u ? cnt : 1u;
}

__device__ __forceinline__ void xcd_barrier(const XcdBarrier& b) {
    asm volatile("s_waitcnt vmcnt(0)" ::: "memory");
    __syncthreads();
    if (b.lead) {
        unsigned* bar = b.bar;
        __builtin_amdgcn_s_waitcnt(0);
        unsigned nloc = b.st[0], nx = b.st[1];
        if (nloc == 0u) { xcd_barrier_complete(bar, b.x, nloc, nx); b.st[0] = nloc; b.st[1] = nx; }
        const unsigned old = xb_add(&bar[XB_XSUB(b.x)], 1u);
        const unsigned gen = old / nloc;
        if (old + 1u == (gen + 1u) * nloc) {
            __builtin_amdgcn_fence(__ATOMIC_RELEASE, "agent");
            asm volatile("s_waitcnt vmcnt(0)" ::: "memory");
            const unsigned og = xb_add(&bar[XB_TOP], 1u);
            const unsigned tg = og / nx;
            if (og + 1u == (tg + 1u) * nx) xb_add(&bar[XB_TOPGEN], 1u);
            else XB_SPIN(xb_ld(&bar[XB_TOPGEN]) == tg, bar);
            __builtin_amdgcn_fence(__ATOMIC_ACQUIRE, "agent");
            xb_add(&bar[XB_XGEN(b.x)], 1u);
            asm volatile("s_waitcnt vmcnt(0)" ::: "memory");
        } else {
            XB_SPIN(xb_ld(&bar[XB_XGEN(b.x)]) == gen, bar);
            __builtin_amdgcn_fence(__ATOMIC_ACQUIRE, "agent");
            asm volatile("s_waitcnt vmcnt(0)" ::: "memory");
        }
    }
    __syncthreads();
}


constexpr int D = 2048, MP = 8192, MS = 4096, M = 12288, DFF = 5632, NFI = 11264, KVROWS = 14336;
constexpr int NWAVES = 8, NTHR = 512;
constexpr float RMS_EPS = 1e-6f, GN_EPS = 64e-5f;
constexpr size_t MiB = 1u << 20;
constexpr size_t WS_CTL = 0, CTL_ZERO_BYTES = 1 * MiB;
constexpr size_t WS_MOD = 1 * MiB;
constexpr size_t WS_X = 4 * MiB;
constexpr size_t WS_H = 100 * MiB;
constexpr size_t WS_U = 148 * MiB;
constexpr size_t WS_WFI = 280 * MiB;
constexpr size_t WS_WFO = 632 * MiB;
constexpr size_t WS_WMLA = 808 * MiB;
constexpr size_t WS_WRW = 848 * MiB;
constexpr size_t WS_ACT = 932 * MiB;
constexpr size_t A_RAW = WS_ACT, A_CQ = WS_ACT + 60 * MiB, A_CKV = WS_ACT + 72 * MiB, A_KR = WS_ACT + 86 * MiB, A_Q = WS_ACT + 88 * MiB, A_KV = WS_ACT + 160 * MiB, A_O = WS_ACT + 272 * MiB;
constexpr size_t B_XMIX = WS_ACT, B_DEC = WS_ACT, B_AA = WS_ACT + 192 * MiB, B_RKV = WS_ACT + 384 * MiB, B_G = WS_ACT + 672 * MiB, B_T1 = WS_ACT + 768 * MiB, B_Y = WS_ACT + 798 * MiB,
                 B_BON = WS_ACT + 990 * MiB, B_O2 = WS_ACT + 993 * MiB;
constexpr size_t WS_END = WS_ACT + 1041 * MiB;
constexpr size_t O_YP = 0, O_YS = 16777216, O_CKV = 25165824, O_KR = 33554432, O_SF = 34603008, O_SB = 42991616, O_END = 51380224;
constexpr int CW_BAR = 4096, CW_DBG = 64;
constexpr int LDS_BYTES = 147456, MISC_OFF = LDS_BYTES - 256;

#define GAS __attribute__((address_space(1)))
typedef unsigned short bf16;
typedef unsigned v4u __attribute__((ext_vector_type(4)));
typedef unsigned v2u __attribute__((ext_vector_type(2)));
typedef float f32x4 __attribute__((ext_vector_type(4)));
typedef float f32x2 __attribute__((ext_vector_type(2)));
typedef short bf16x8 __attribute__((ext_vector_type(8)));
typedef short s16x4 __attribute__((ext_vector_type(4)));
#define LDS_WAIT() asm volatile("s_waitcnt lgkmcnt(0)" ::: "memory")
__device__ __forceinline__ unsigned f2bf(float f) { unsigned u = __builtin_bit_cast(unsigned, f); return (u + 0x7fffu + ((u >> 16) & 1u)) >> 16; }
__device__ __forceinline__ unsigned pk2(float lo, float hi) { return f2bf(lo) | (f2bf(hi) << 16); }
__device__ __forceinline__ float bflo(unsigned w) { return __builtin_bit_cast(float, w << 16); }
__device__ __forceinline__ float bfhi(unsigned w) { return __builtin_bit_cast(float, w & 0xffff0000u); }
__device__ __forceinline__ float xdpp(float v, int ctrl_b1_or_4e) { return ctrl_b1_or_4e == 1 ? __builtin_bit_cast(float, __builtin_amdgcn_update_dpp(0, __builtin_bit_cast(int, v), 0xB1, 0xF, 0xF, true))
                                                                                             : __builtin_bit_cast(float, __builtin_amdgcn_update_dpp(0, __builtin_bit_cast(int, v), 0x4E, 0xF, 0xF, true)); }
__device__ __forceinline__ float xswz4(float v) { return __builtin_bit_cast(float, __builtin_amdgcn_ds_swizzle(__builtin_bit_cast(int, v), 0x101F)); }
__device__ __forceinline__ float xswz8(float v) { return __builtin_bit_cast(float, __builtin_amdgcn_ds_swizzle(__builtin_bit_cast(int, v), 0x201F)); }
__device__ __forceinline__ float xswz16(float v) { return __builtin_bit_cast(float, __builtin_amdgcn_ds_swizzle(__builtin_bit_cast(int, v), 0x401F)); }
__device__ __forceinline__ float sum_x32(float v) { unsigned a_ = __builtin_bit_cast(unsigned, v), b_ = a_; asm volatile("" : "+v"(b_));
    auto r = __builtin_amdgcn_permlane32_swap(a_, b_, false, false); const unsigned r0 = r[0], r1 = r[1];
    return __builtin_bit_cast(float, r0) + __builtin_bit_cast(float, r1); }
__device__ __forceinline__ float max_x32(float v) { unsigned a_ = __builtin_bit_cast(unsigned, v), b_ = a_; asm volatile("" : "+v"(b_));
    auto r = __builtin_amdgcn_permlane32_swap(a_, b_, false, false); const unsigned r0 = r[0], r1 = r[1];
    return fmaxf(__builtin_bit_cast(float, r0), __builtin_bit_cast(float, r1)); }
__device__ __forceinline__ float quad_sum(float v) { v += xdpp(v, 1); v += xdpp(v, 2); return v; }
__device__ __forceinline__ float sum16(float v) { v = quad_sum(v);
    v += __builtin_bit_cast(float, __builtin_amdgcn_update_dpp(0, __builtin_bit_cast(int, v), 0x141, 0xF, 0xF, true));
    v += __builtin_bit_cast(float, __builtin_amdgcn_update_dpp(0, __builtin_bit_cast(int, v), 0x140, 0xF, 0xF, true));
    return v; }
__device__ __forceinline__ float wave_sum(float v) { v = sum16(v); v += xswz16(v); return sum_x32(v); }

struct Params { const float* in[40]; float* out; unsigned char* ws; int ph_lo, ph_hi; };
#define CAS __attribute__((address_space(4)))
struct InProxy { const CAS Params* p; __device__ __forceinline__ const float* operator[](int i) const { return p->in[i]; } };
struct PP { InProxy in; float* out; unsigned char* ws; };
__device__ __forceinline__ PP make_pp() {
    const unsigned long long a = (unsigned long long)(const CAS void*)__builtin_amdgcn_kernarg_segment_ptr(); const unsigned lo_ = (unsigned)pg8::opaque_s((int)(unsigned)a), hi_ = (unsigned)pg8::opaque_s((int)(unsigned)(a >> 32));
    const CAS Params* p = (const CAS Params*)(((unsigned long long)hi_ << 32) | lo_); PP r; r.in.p = p; r.out = p->out; r.ws = p->ws; return r; }
using pg8::opaque_v; using pg8::opaque_s;
struct Ctx {
    LAS unsigned char* lds; int tid, lane, wave, G, vcu, gw, ngw;
};

struct TJob { const float* W; bf16* WT; int K, N, ldw, Kpad, Npad, ldk, mode, row_off; };
__device__ __forceinline__ void transpose_item(const TJob& J, int item, LAS float* scr, int lane) {
    const int nblk = J.Npad >> 6, kb = item / nblk, nb = item - kb * nblk, k0 = kb << 6, n0 = nb << 6;
    const int kq = lane >> 4, nq = lane & 15, n = n0 + 4 * nq; const bool nok = n < J.N;
    f32x4 v[16];
#pragma unroll
    for (int i = 0; i < 16; ++i) { const int k = k0 + 4 * i + kq; v[i] = (f32x4){0.f, 0.f, 0.f, 0.f}; if (nok && k < J.K) v[i] = __builtin_nontemporal_load((const f32x4*)(J.W + (size_t)k * J.ldw + n)); }
#pragma unroll
    for (int i = 0; i < 16; ++i) { LAS float* s = scr + (4 * i + kq) * 65 + 4 * nq; s[0] = v[i][0]; s[1] = v[i][1]; s[2] = v[i][2]; s[3] = v[i][3];
        if ((i & 3) == 3) asm volatile("s_waitcnt lgkmcnt(4)" ::: "memory"); }
    LDS_WAIT(); asm volatile("" ::: "memory");
    int rbase;
    if (J.mode == 1) rbase = n0 < DFF ? (n0 >> 7) * 256 + (n0 & 127) : ((n0 - DFF) >> 7) * 256 + 128 + ((n0 - DFF) & 127);
    else rbase = J.row_off + n0;
    const int nn = lane >> 3, c = lane & 7;
    float t[2][8];
#pragma unroll
    for (int e = 0; e < 8; ++e) t[0][e] = (scr + (8 * c) * 65 + nn)[e * 65];
#pragma unroll
    for (int j = 0; j < 8; ++j) { const int nl = nn + 8 * j;
        if (j + 1 < 8) { const LAS float* s = scr + (8 * c) * 65 + nl + 8;
#pragma unroll
            for (int e = 0; e < 8; ++e) t[(j + 1) & 1][e] = s[e * 65];
            asm volatile("s_waitcnt lgkmcnt(8)" ::: "memory"); }
        else asm volatile("s_waitcnt lgkmcnt(0)" ::: "memory");
        v4u o; o.x = pk2(t[j & 1][0], t[j & 1][1]); o.y = pk2(t[j & 1][2], t[j & 1][3]); o.z = pk2(t[j & 1][4], t[j & 1][5]); o.w = pk2(t[j & 1][6], t[j & 1][7]);
        __builtin_nontemporal_store(o, (v4u*)(J.WT + (size_t)(rbase + nl) * J.ldk + k0 + 8 * c)); }
    LDS_WAIT(); asm volatile("" ::: "memory");
}
constexpr int IT_FI = 32 * 176, IT_FO = 88 * 32, IT_MLA = 2560, IT_RW = 5376;
constexpr int IT_TOTAL = 8 * IT_FI + 8 * IT_FO + 2 * IT_MLA + 2 * IT_RW;
__device__ __forceinline__ void make_job(const PP& P, int it, TJob& J, int& item) {
    unsigned char* ws = P.ws;
    J.mode = 0; J.row_off = 0;
    if (it < 8 * IT_FI) { const int mi = it / IT_FI; item = it - mi * IT_FI; J.W = P.in[12] + (size_t)mi * D * NFI; J.WT = (bf16*)(ws + WS_WFI) + (size_t)mi * NFI * D; J.K = D; J.N = NFI; J.ldw = NFI; J.Kpad = D; J.Npad = NFI; J.ldk = D; J.mode = 1; return; }
    it -= 8 * IT_FI;
    if (it < 8 * IT_FO) { const int mi = it / IT_FO; item = it - mi * IT_FO; J.W = P.in[13] + (size_t)mi * DFF * D; J.WT = (bf16*)(ws + WS_WFO) + (size_t)mi * D * DFF; J.K = DFF; J.N = D; J.ldw = D; J.Kpad = DFF; J.Npad = D; J.ldk = DFF; return; }
    it -= 8 * IT_FO;
    if (it < 2 * IT_MLA) { const int j = it / IT_MLA; it -= j * IT_MLA; unsigned char* wb = ws + WS_WMLA + (size_t)j * 20 * MiB;
        if (it < 256) { item = it; J.W = P.in[14] + (size_t)j * D * 512; J.WT = (bf16*)wb; J.K = D; J.N = 512; J.ldw = 512; J.Kpad = D; J.Npad = 512; J.ldk = D; return; }
        it -= 256;
        if (it < 288) { item = it; J.W = P.in[17] + (size_t)j * D * 576; J.WT = (bf16*)wb; J.K = D; J.N = 576; J.ldw = 576; J.Kpad = D; J.Npad = 576; J.ldk = D; J.row_off = 512; return; }
        it -= 288;
        if (it < 96) { item = it; J.W = P.in[17]; J.WT = (bf16*)wb; J.K = D; J.N = 0; J.ldw = 576; J.Kpad = D; J.Npad = 192; J.ldk = D; J.row_off = 1088; return; }
        it -= 96;
        if (it < 384) { item = it; J.W = P.in[16] + (size_t)j * 512 * 3072; J.WT = (bf16*)(wb + 5 * MiB); J.K = 512; J.N = 3072; J.ldw = 3072; J.Kpad = 512; J.Npad = 3072; J.ldk = 512; return; }
        it -= 384;
        if (it < 512) { item = it; J.W = P.in[19] + (size_t)j * 512 * 4096; J.WT = (bf16*)(wb + 8 * MiB); J.K = 512; J.N = 4096; J.ldw = 4096; J.Kpad = 512; J.Npad = 4096; J.ldk = 512; return; }
        it -= 512;
        item = it; J.W = P.in[20] + (size_t)j * D * D; J.WT = (bf16*)(wb + 12 * MiB); J.K = D; J.N = D; J.ldw = D; J.Kpad = D; J.Npad = D; J.ldk = D; return; }
    it -= 2 * IT_MLA;
    { const int j = it / IT_RW; it -= j * IT_RW; unsigned char* wb = ws + WS_WRW + (size_t)j * 42 * MiB;
        if (it < 3072) { const int mi = it >> 10; item = it & 1023; J.W = P.in[23 + mi] + (size_t)j * D * D; J.WT = (bf16*)wb; J.K = D; J.N = D; J.ldw = D; J.Kpad = D; J.Npad = D; J.ldk = D; J.row_off = mi * D; return; }
        it -= 3072;
        if (it < 640) { const int slot = it >> 7; item = it & 127; J.WT = (bf16*)wb; J.K = D; J.Kpad = D; J.Npad = 256; J.ldk = D; J.row_off = 6144 + slot * 256;
            if (slot == 0) { J.W = P.in[32] + (size_t)j * D * 256; J.N = 256; J.ldw = 256; }
            else { const int dir = (slot - 1) >> 1, isa = (slot - 1) & 1; J.W = P.in[isa ? 30 : 27] + (size_t)(j * 2 + dir) * D * 96; J.N = 96; J.ldw = 96; }
            return; }
        it -= 640;
        if (it < 640) { const int slot = it >> 7; item = it & 127; J.WT = (bf16*)(wb + 29 * MiB); J.Kpad = 256; J.N = D; J.ldw = D; J.Npad = D; J.ldk = 256; J.row_off = slot * D;
            if (slot == 0) { J.W = P.in[33] + (size_t)j * 256 * D; J.K = 256; }
            else { const int dir = (slot - 1) >> 1, isa = (slot - 1) & 1; J.W = P.in[isa ? 31 : 28] + (size_t)(j * 2 + dir) * 96 * D; J.K = 96; }
            return; }
        it -= 640;
        item = it; J.W = P.in[39] + (size_t)j * D * D; J.WT = (bf16*)(wb + 34 * MiB); J.K = D; J.N = D; J.ldw = D; J.Kpad = D; J.Npad = D; J.ldk = D; return; }
}
__device__ __forceinline__ void ada_strip(const PP& P, int s, int lane) {
    const int l = s / 288, col = (s - l * 288) * 64 + lane;
    const float* W = P.in[8] + (size_t)l * D * 18432 + col;
    float acc[5] = {0.f, 0.f, 0.f, 0.f, 0.f};
    for (int kc = 0; kc < D; kc += 64) {
        float sv[5];
#pragma unroll
        for (int g = 0; g < 5; ++g) { const float x = g == 0 ? P.in[7][kc + lane] : P.in[6][(g - 1) * D + kc + lane]; sv[g] = x / (1.0f + __expf(-x)); }
#pragma unroll 16
        for (int j = 0; j < 64; ++j) { const float w = __builtin_nontemporal_load(W + (size_t)(kc + j) * 18432);
#pragma unroll
            for (int g = 0; g < 5; ++g) acc[g] += __builtin_bit_cast(float, __builtin_amdgcn_readlane(__builtin_bit_cast(int, sv[g]), j)) * w; }
    }
    float* mod = (float*)(P.ws + WS_MOD);
    const float b = P.in[9][(size_t)l * 18432 + col];
#pragma unroll
    for (int g = 0; g < 5; ++g) mod[(size_t)(l * 5 + g) * 18432 + col] = acc[g] + b;
}
constexpr int IT_EARLY = 4 * IT_FI + 4 * IT_FO + IT_MLA + IT_RW, IT_LATE_A = 3 * IT_FI + 3 * IT_FO + IT_MLA + IT_RW, IT_LATE_B = IT_FI + IT_FO;
static_assert(IT_EARLY + IT_LATE_A + IT_LATE_B == IT_TOTAL, "item split");
__device__ __forceinline__ int early_item(int e) {
    if (e < 4 * IT_FI) { const int q = e / IT_FI, r = e - q * IT_FI; return (q < 3 ? q : 6) * IT_FI + r; } e -= 4 * IT_FI;
    if (e < 4 * IT_FO) { const int q = e / IT_FO, r = e - q * IT_FO; return 8 * IT_FI + (q < 3 ? q : 6) * IT_FO + r; } e -= 4 * IT_FO;
    if (e < IT_MLA) return 8 * IT_FI + 8 * IT_FO + e; e -= IT_MLA;
    return 8 * IT_FI + 8 * IT_FO + 2 * IT_MLA + e;
}
__device__ __forceinline__ int late_item(int t, int set) {
    if (set == 0) {
        if (t < 3 * IT_FI) return 3 * IT_FI + t; t -= 3 * IT_FI;
        if (t < 3 * IT_FO) return 8 * IT_FI + 3 * IT_FO + t; t -= 3 * IT_FO;
        if (t < IT_MLA) return 8 * IT_FI + 8 * IT_FO + IT_MLA + t; t -= IT_MLA;
        return 8 * IT_FI + 8 * IT_FO + 2 * IT_MLA + IT_RW + t;
    }
    if (t < IT_FI) return 7 * IT_FI + t; t -= IT_FI;
    return 8 * IT_FI + 7 * IT_FO + t;
}
__device__ __forceinline__ void p0_prologue(const PP& P, const Ctx& C) {
    LAS float* scr = (LAS float*)(C.lds + C.wave * 16640);
    for (int s = C.gw; s < 1152; s += C.ngw) ada_strip(P, s, C.lane);
    for (int e = (C.ngw - 1 - C.gw); e < IT_EARLY; e += C.ngw) { TJob J; int item; make_job(P, early_item(e), J, item); transpose_item(J, item, scr, C.lane); }
    v4u* X8 = (v4u*)(P.ws + WS_X); const f32x4* xp = (const f32x4*)P.in[0]; const f32x4* xs = (const f32x4*)P.in[1];
    const int nthr = C.G * NTHR; constexpr int NP8 = MP * D / 8, NA8 = M * D / 8;
    for (int i = C.vcu * NTHR + C.tid; i < NA8; i += nthr) { const f32x4* s = i < NP8 ? xp + 2 * (size_t)i : xs + 2 * (size_t)(i - NP8); const f32x4 a = s[0], b = s[1];
        v4u w; w.x = pk2(a[0], a[1]); w.y = pk2(a[2], a[3]); w.z = pk2(b[0], b[1]); w.w = pk2(b[2], b[3]); X8[i] = w; }
}

__device__ __forceinline__ int grp_of_row(int r) { return r < MP ? 0 : 1 + ((r - MP) >> 10); }
__device__ __forceinline__ void phase_norm(const PP& P, const Ctx& C, int l, int s) {
    const bf16* X = (const bf16*)(P.ws + WS_X); bf16* H = (bf16*)(P.ws + WS_H);
    const float* g = P.in[10] + (size_t)(l * 3 + s) * D; const float* mod = (const float*)(P.ws + WS_MOD) + (size_t)l * 5 * 18432;
    int cur = -1; f32x4 ca[8], cb[8];
    for (int r = C.gw; r < M; r += C.ngw) {
        const int grp = grp_of_row(r);
        if (grp != cur) { cur = grp; const float* sh = mod + (size_t)grp * 18432 + (3 * s) * D; const float* sc = sh + D;
#pragma unroll
            for (int j = 0; j < 8; ++j) { const int c = 8 * C.lane + 512 * (j >> 1) + 4 * (j & 1); const f32x4 gg = *(const f32x4*)(g + c), ss = *(const f32x4*)(sc + c); ca[j] = gg * (ss + 1.0f); cb[j] = *(const f32x4*)(sh + c); } }
        f32x4 v[8]; float q = 0.f;
        if (l == 0 && s == 0) {
            const float* xsrc = r < MP ? P.in[0] + (size_t)r * D : P.in[1] + (size_t)(r - MP) * D;
#pragma unroll
            for (int j = 0; j < 8; ++j) v[j] = *(const f32x4*)(xsrc + 8 * C.lane + 512 * (j >> 1) + 4 * (j & 1));
        } else {
#pragma unroll
            for (int jj = 0; jj < 4; ++jj) { const v4u w = *(const v4u*)(X + (size_t)r * D + 8 * C.lane + 512 * jj);
                v[2 * jj] = (f32x4){bflo(w.x), bfhi(w.x), bflo(w.y), bfhi(w.y)}; v[2 * jj + 1] = (f32x4){bflo(w.z), bfhi(w.z), bflo(w.w), bfhi(w.w)}; }
        }
#pragma unroll
        for (int j = 0; j < 8; ++j) q += (v[j][0] * v[j][0] + v[j][1] * v[j][1]) + (v[j][2] * v[j][2] + v[j][3] * v[j][3]);
        const float rstd = 1.0f / sqrtf(wave_sum(q) * (1.0f / D) + RMS_EPS);
#pragma unroll
        for (int jj = 0; jj < 4; ++jj) { const f32x4 y0 = v[2 * jj] * rstd * ca[2 * jj] + cb[2 * jj], y1 = v[2 * jj + 1] * rstd * ca[2 * jj + 1] + cb[2 * jj + 1];
            v4u w; w.x = pk2(y0[0], y0[1]); w.y = pk2(y0[2], y0[3]); w.z = pk2(y1[0], y1[1]); w.w = pk2(y1[2], y1[3]); *(v4u*)(H + (size_t)r * D + 8 * C.lane + 512 * jj) = w; }
    }
}
__device__ __forceinline__ void phase_final(const PP& P, const Ctx& C) {
    const bf16* X = (const bf16*)(P.ws + WS_X); const float* g = P.in[11];
    f32x4 ca[8];
#pragma unroll
    for (int j = 0; j < 8; ++j) ca[j] = *(const f32x4*)(g + 8 * C.lane + 512 * (j >> 1) + 4 * (j & 1));
    for (int r = C.gw; r < M; r += C.ngw) {
        f32x4 v[8]; float q = 0.f;
#pragma unroll
        for (int jj = 0; jj < 4; ++jj) { const v4u w = *(const v4u*)(X + (size_t)r * D + 8 * C.lane + 512 * jj);
            v[2 * jj] = (f32x4){bflo(w.x), bfhi(w.x), bflo(w.y), bfhi(w.y)}; v[2 * jj + 1] = (f32x4){bflo(w.z), bfhi(w.z), bflo(w.w), bfhi(w.w)}; }
#pragma unroll
        for (int j = 0; j < 8; ++j) q += (v[j][0] * v[j][0] + v[j][1] * v[j][1]) + (v[j][2] * v[j][2] + v[j][3] * v[j][3]);
        const float rstd = 1.0f / sqrtf(wave_sum(q) * (1.0f / D) + RMS_EPS);
        float* o = P.out + O_YP + (size_t)r * D + 8 * C.lane;
#pragma unroll
        for (int j = 0; j < 8; ++j) *(f32x4*)(o + 512 * (j >> 1) + 4 * (j & 1)) = v[j] * rstd * ca[j];
    }
}

__device__ __forceinline__ float rope_inv(int f) { return __expf(-(float)f * (9.210340372f / 16.0f)); }
__device__ __forceinline__ float rope_lane(float x, int lane, int t) {
    const float xp = xswz16(x);
    const int axis = lane >> 5, half = (lane >> 4) & 1, f = lane & 15;
    const float pos = (float)(axis == 0 ? (t >> 6) : (t & 63)); const float ang = pos * rope_inv(f);
    float sn, cs; sincosf(ang, &sn, &cs);
    return half == 0 ? x * cs - xp * sn : x * cs + xp * sn;
}
__device__ __forceinline__ void phase_mla_norm(const PP& P, const Ctx& C, int j) {
    const float* RAW = (const float*)(P.ws + A_RAW); bf16* CQ = (bf16*)(P.ws + A_CQ); bf16* CKV = (bf16*)(P.ws + A_CKV); bf16* KR = (bf16*)(P.ws + A_KR);
    const float* qn = P.in[15] + j * 512; const float* kn = P.in[18] + j * 512;
    f32x4 gq[2], gk[2];
#pragma unroll
    for (int jj = 0; jj < 2; ++jj) { gq[jj] = *(const f32x4*)(qn + 4 * C.lane + 256 * jj); gk[jj] = *(const f32x4*)(kn + 4 * C.lane + 256 * jj); }
    for (int r = C.gw; r < M + 2048; r += C.ngw) {
        if (r < M) {
            const float* rw = RAW + (size_t)r * 1280;
            f32x4 a[2], b[2]; float qa = 0.f, qb = 0.f;
#pragma unroll
            for (int jj = 0; jj < 2; ++jj) { a[jj] = *(const f32x4*)(rw + 4 * C.lane + 256 * jj); b[jj] = *(const f32x4*)(rw + 512 + 4 * C.lane + 256 * jj);
                qa += (a[jj][0] * a[jj][0] + a[jj][1] * a[jj][1]) + (a[jj][2] * a[jj][2] + a[jj][3] * a[jj][3]); qb += (b[jj][0] * b[jj][0] + b[jj][1] * b[jj][1]) + (b[jj][2] * b[jj][2] + b[jj][3] * b[jj][3]); }
            const float kr = rw[1024 + C.lane];
            const float ra = 1.0f / sqrtf(wave_sum(qa) * (1.0f / 512) + RMS_EPS), rb = 1.0f / sqrtf(wave_sum(qb) * (1.0f / 512) + RMS_EPS);
            int kvrow; float krv = kr;
            if (r < MP) { kvrow = r; const int b_ = r >> 8, t = r & 255;
                float* oc = P.out + O_CKV + ((size_t)(b_ * 2 + j) * 256 + t) * 512;
#pragma unroll
                for (int jj = 0; jj < 2; ++jj) *(f32x4*)(oc + 4 * C.lane + 256 * jj) = b[jj] * rb * gk[jj];
                P.out[O_KR + ((size_t)(b_ * 2 + j) * 256 + t) * 64 + C.lane] = kr;
            } else { const int lb = (r - MP) >> 10, t = (r - MP) & 1023; kvrow = MP + lb * 1536 + 512 + t; krv = rope_lane(kr, C.lane, t); }
#pragma unroll
            for (int jj = 0; jj < 2; ++jj) { const f32x4 y = a[jj] * ra * gq[jj]; v2u w; w.x = pk2(y[0], y[1]); w.y = pk2(y[2], y[3]); *(v2u*)(CQ + (size_t)r * 512 + 4 * C.lane + 256 * jj) = w;
                const f32x4 z = b[jj] * rb * gk[jj]; v2u w2; w2.x = pk2(z[0], z[1]); w2.y = pk2(z[2], z[3]); *(v2u*)(CKV + (size_t)kvrow * 512 + 4 * C.lane + 256 * jj) = w2; }
            KR[(size_t)kvrow * 64 + C.lane] = (bf16)f2bf(krv);
        } else {
            const int q = r - M, lb = q >> 9, s = q & 511, kvrow = MP + lb * 1536 + s;
            const float* cc = P.in[2] + ((size_t)(lb * 2 + j) * 512 + s) * 512;
#pragma unroll
            for (int jj = 0; jj < 2; ++jj) { const f32x4 z = *(const f32x4*)(cc + 4 * C.lane + 256 * jj); v2u w2; w2.x = pk2(z[0], z[1]); w2.y = pk2(z[2], z[3]); *(v2u*)(CKV + (size_t)kvrow * 512 + 4 * C.lane + 256 * jj) = w2; }
            KR[(size_t)kvrow * 64 + C.lane] = (bf16)f2bf(P.in[3][((size_t)(lb * 2 + j) * 512 + s) * 64 + C.lane]);
        }
    }
}
__device__ __forceinline__ void phase_q_rope(const PP& P, const Ctx& C) {
    bf16* Q = (bf16*)(P.ws + A_Q);
    for (int it = C.gw; it < MS * 16; it += C.ngw) { const int rr = it >> 4, h = it & 15, t = rr & 1023;
        bf16* p = Q + (size_t)(MP + rr) * 3072 + h * 192 + 128 + C.lane;
        const float x = __builtin_bit_cast(float, (unsigned)(*p) << 16);
        *p = (bf16)f2bf(rope_lane(x, C.lane, t)); }
}

constexpr int AT_KSTR = 400, AT_VSTR = 288, AT_KBUF = 64 * AT_KSTR, AT_VBUF = 64 * AT_VSTR, AT_BUF = AT_KBUF + AT_VBUF;
__device__ __forceinline__ void attn_unit(const Ctx& C, const bf16* Q, const bf16* KV, const bf16* KR, bf16* O, int qrow0, int krow0, int T, int h, bool rope) {
    const int tid = C.tid, lane = C.lane, wave = C.wave, fr = lane & 15, fq = lane >> 4;
    LAS unsigned char* lds = C.lds;
    bf16x8 qf[2][6];
#pragma unroll
    for (int qb = 0; qb < 2; ++qb)
#pragma unroll
        for (int ks = 0; ks < 6; ++ks) qf[qb][ks] = *(const bf16x8*)(Q + (size_t)(qrow0 + wave * 32 + qb * 16 + fr) * 3072 + h * 192 + ks * 32 + fq * 8);
    if (rope) {
        const int half = fq >> 1, f0 = (fq & 1) * 8, paddr = (lane ^ 32) << 2;
#pragma unroll
        for (int qb = 0; qb < 2; ++qb) { const int t = (qrow0 + wave * 32 + qb * 16 + fr - MP) & 1023;
#pragma unroll
            for (int ax = 0; ax < 2; ++ax) { const float pos = (float)(ax == 0 ? (t >> 6) : (t & 63));
                const v4u own = __builtin_bit_cast(v4u, qf[qb][4 + ax]); v4u par, outw;
#pragma unroll
                for (int d = 0; d < 4; ++d) par[d] = (unsigned)__builtin_amdgcn_ds_bpermute(paddr, (int)own[d]);
#pragma unroll
                for (int d = 0; d < 4; ++d) { float o2[2];
#pragma unroll
                    for (int e = 0; e < 2; ++e) { const int f = f0 + 2 * d + e; const float rev = pos * rope_inv(f) * 0.15915494309189535f; const float sn = __builtin_amdgcn_sinf(rev), cs = __builtin_amdgcn_cosf(rev);
                        const float x = e ? bfhi(own[d]) : bflo(own[d]), xp = e ? bfhi(par[d]) : bflo(par[d]);
                        o2[e] = half == 0 ? x * cs - xp * sn : x * cs + xp * sn; }
                    outw[d] = pk2(o2[0], o2[1]); }
                qf[qb][4 + ax] = __builtin_bit_cast(bf16x8, outw); } }
    }
    f32x4 ot[2][8];
#pragma unroll
    for (int qb = 0; qb < 2; ++qb)
#pragma unroll
        for (int db = 0; db < 8; ++db) ot[qb][db] = (f32x4){0.f, 0.f, 0.f, 0.f};
    float mrun[2] = {-1e30f, -1e30f}, lrun[2] = {0.f, 0.f};
    const int nt = T >> 6;
    v4u st[5];
    const int key01 = tid >> 4, ch01 = tid & 15, key4 = tid >> 3, ch4 = tid & 7;
#define AT_LOAD(t) do { const size_t kr0 = (size_t)krow0 + (size_t)(t) * 64; \
        st[0] = *(const v4u*)(KV + (kr0 + key01) * 4096 + h * 256 + ch01 * 8); st[1] = *(const v4u*)(KV + (kr0 + 32 + key01) * 4096 + h * 256 + ch01 * 8); \
        st[2] = *(const v4u*)(KV + (kr0 + key01) * 4096 + h * 256 + 128 + ch01 * 8); st[3] = *(const v4u*)(KV + (kr0 + 32 + key01) * 4096 + h * 256 + 128 + ch01 * 8); \
        st[4] = *(const v4u*)(KR + (kr0 + key4) * 64 + ch4 * 8); } while (0)
#define AT_WRITE(b) do { LAS unsigned char* kb_ = lds + (b) * AT_BUF; LAS unsigned char* vb_ = kb_ + AT_KBUF; \
        *(LAS v4u*)(kb_ + key01 * AT_KSTR + ch01 * 16) = st[0]; *(LAS v4u*)(kb_ + (32 + key01) * AT_KSTR + ch01 * 16) = st[1]; \
        *(LAS v4u*)(vb_ + key01 * AT_VSTR + ch01 * 16) = st[2]; *(LAS v4u*)(vb_ + (32 + key01) * AT_VSTR + ch01 * 16) = st[3]; \
        *(LAS v4u*)(kb_ + key4 * AT_KSTR + 256 + ch4 * 16) = st[4]; } while (0)
    AT_LOAD(0); AT_WRITE(0);
    __syncthreads();
    const float sc2 = 0.07216878364870322f * 1.44269504088896f;
    for (int t = 0; t < nt; ++t) {
        if (t + 1 < nt) AT_LOAD(t + 1);
        LAS unsigned char* kb = lds + (t & 1) * AT_BUF; LAS unsigned char* vb = kb + AT_KBUF;
        f32x4 sacc[2][4];
#pragma unroll
        for (int qb = 0; qb < 2; ++qb)
#pragma unroll
            for (int kk = 0; kk < 4; ++kk) sacc[qb][kk] = (f32x4){0.f, 0.f, 0.f, 0.f};
#pragma unroll
        for (int ks = 0; ks < 6; ++ks)
#pragma unroll
            for (int kk = 0; kk < 4; ++kk) { const bf16x8 kf = *(const LAS bf16x8*)(kb + (kk * 16 + fr) * AT_KSTR + ks * 64 + fq * 16);
#pragma unroll
                for (int qb = 0; qb < 2; ++qb) sacc[qb][kk] = __builtin_amdgcn_mfma_f32_16x16x32_bf16(kf, qf[qb][ks], sacc[qb][kk], 0, 0, 0); }
        bf16x8 pf[2][2];
#pragma unroll
        for (int qb = 0; qb < 2; ++qb) {
            float mx = -1e30f;
#pragma unroll
            for (int kk = 0; kk < 4; ++kk)
#pragma unroll
                for (int e = 0; e < 4; ++e) { sacc[qb][kk][e] *= sc2; mx = fmaxf(mx, sacc[qb][kk][e]); }
            mx = fmaxf(mx, xswz16(mx)); mx = max_x32(mx);
            const float mnew = fmaxf(mrun[qb], mx), alpha = __builtin_amdgcn_exp2f(mrun[qb] - mnew);
            mrun[qb] = mnew;
            float ps = 0.f;
#pragma unroll
            for (int kk = 0; kk < 4; ++kk)
#pragma unroll
                for (int e = 0; e < 4; ++e) { const float p = __builtin_amdgcn_exp2f(sacc[qb][kk][e] - mnew); sacc[qb][kk][e] = p; ps += p; }
            lrun[qb] = lrun[qb] * alpha + ps;
#pragma unroll
            for (int db = 0; db < 8; ++db) ot[qb][db] = ot[qb][db] * alpha;
#pragma unroll
            for (int k2 = 0; k2 < 2; ++k2) { v4u w; w.x = pk2(sacc[qb][2 * k2][0], sacc[qb][2 * k2][1]); w.y = pk2(sacc[qb][2 * k2][2], sacc[qb][2 * k2][3]);
                w.z = pk2(sacc[qb][2 * k2 + 1][0], sacc[qb][2 * k2 + 1][1]); w.w = pk2(sacc[qb][2 * k2 + 1][2], sacc[qb][2 * k2 + 1][3]); pf[qb][k2] = __builtin_bit_cast(bf16x8, w); }
        }
#pragma unroll
        for (int db = 0; db < 8; ++db)
#pragma unroll
            for (int k2 = 0; k2 < 2; ++k2) {
                const s16x4 lo = __builtin_amdgcn_ds_read_tr16_b64_v4i16((LAS s16x4*)(vb + (k2 * 32 + fq * 4 + (fr >> 2)) * AT_VSTR + db * 32 + 8 * (fr & 3)));
                const s16x4 hi = __builtin_amdgcn_ds_read_tr16_b64_v4i16((LAS s16x4*)(vb + (k2 * 32 + 16 + fq * 4 + (fr >> 2)) * AT_VSTR + db * 32 + 8 * (fr & 3)));
                const bf16x8 vf = __builtin_shufflevector(lo, hi, 0, 1, 2, 3, 4, 5, 6, 7);
#pragma unroll
                for (int qb = 0; qb < 2; ++qb) ot[qb][db] = __builtin_amdgcn_mfma_f32_16x16x32_bf16(vf, pf[qb][k2], ot[qb][db], 0, 0, 0);
            }
        if (t + 1 < nt) AT_WRITE((t + 1) & 1);
        __syncthreads();
    }
#undef AT_LOAD
#undef AT_WRITE
#pragma unroll
    for (int qb = 0; qb < 2; ++qb) {
        float l = lrun[qb]; l += xswz16(l); l = sum_x32(l);
        const float inv = 1.0f / l;
        bf16* op = O + (size_t)(qrow0 + wave * 32 + qb * 16 + fr) * 2048 + h * 128 + fq * 4;
#pragma unroll
        for (int db = 0; db < 8; ++db) { const f32x4 o = ot[qb][db] * inv; v2u w; w.x = pk2(o[0], o[1]); w.y = pk2(o[2], o[3]); *(v2u*)(op + db * 16) = w; }
    }
}
__device__ __forceinline__ void phase_attn(const PP& P, const Ctx& C) {
    const bf16* Q = (const bf16*)(P.ws + A_Q); const bf16* KV = (const bf16*)(P.ws + A_KV); const bf16* KR = (const bf16*)(P.ws + A_KR); bf16* O = (bf16*)(P.ws + A_O);
    for (int vc = C.vcu; vc < 256; vc += C.G) {
#pragma unroll 1
        for (int k = 0; k < 3; ++k) {
            int qrow0, krow0, T, h;
            if (k == 0) { const int lb = vc >> 6, qblk = vc & 3; h = (vc >> 2) & 15; qrow0 = MP + lb * 1024 + qblk * 256; krow0 = MP + lb * 1536; T = 1536; }
            else { const int u = vc + 256 * (k - 1), b = u >> 4; h = u & 15; qrow0 = b * 256; krow0 = b * 256; T = 256; }
            attn_unit(C, Q, KV, KR, O, qrow0, krow0, T, h, k == 0);
        }
    }
}

__device__ __forceinline__ void phase_shift(const PP& P, const Ctx& C, int j) {
    const bf16* H = (const bf16*)(P.ws + WS_H); bf16* XM = (bf16*)(P.ws + B_XMIX);
    const float* mu = P.in[21] + (size_t)j * 4 * D; const float* mud = P.in[22] + (size_t)j * 4 * D;
    for (int it = C.gw; it < 2048; it += C.ngw) {
        const int cs = it & 3, r0 = (it >> 2) * 24, c = cs * 512 + 8 * C.lane;
        f32x4 m0[8], m1[8];
#pragma unroll
        for (int i = 0; i < 8; ++i) { const float* mp = (i < 4 ? mu + i * D : mud + (i - 4) * D) + c; m0[i] = *(const f32x4*)mp; m1[i] = *(const f32x4*)(mp + 4); }
        const v4u zero4 = (v4u){0u, 0u, 0u, 0u};
        v4u hp = r0 > 0 ? *(const v4u*)(H + (size_t)(r0 - 1) * D + c) : zero4, hc = *(const v4u*)(H + (size_t)r0 * D + c);
#pragma unroll 4
        for (int i = 0; i < 24; ++i) { const int r = r0 + i;
            const bool isfirst = r < MP ? ((r & 255) == 0) : (((r - MP) & 1023) == 0), islast = r < MP ? ((r & 255) == 255) : (((r - MP) & 1023) == 1023);
            const v4u hn = r + 1 < M ? *(const v4u*)(H + (size_t)(r + 1) * D + c) : zero4;
            const v4u hpu = isfirst ? zero4 : hp, hnu = islast ? zero4 : hn;
            float hv[8], xx[8];
#pragma unroll
            for (int e = 0; e < 4; ++e) { hv[2 * e] = bflo(hc[e]); hv[2 * e + 1] = bfhi(hc[e]);
                xx[2 * e] = 0.5f * (bflo(hpu[e]) + bflo(hnu[e])) - hv[2 * e]; xx[2 * e + 1] = 0.5f * (bfhi(hpu[e]) + bfhi(hnu[e])) - hv[2 * e + 1]; }
#pragma unroll
            for (int k = 0; k < 8; ++k) {
                v4u o; o.x = pk2(hv[0] + xx[0] * m0[k][0], hv[1] + xx[1] * m0[k][1]); o.y = pk2(hv[2] + xx[2] * m0[k][2], hv[3] + xx[3] * m0[k][3]);
                o.z = pk2(hv[4] + xx[4] * m1[k][0], hv[5] + xx[5] * m1[k][1]); o.w = pk2(hv[6] + xx[6] * m1[k][2], hv[7] + xx[7] * m1[k][3]);
                __builtin_nontemporal_store(o, (v4u*)(XM + (size_t)k * M * D + (size_t)r * D + c)); }
            hp = hc; hc = hn;
        }
    }
}

constexpr int SC_STEP = 1536, SC_TC = 4, SC_BUF = SC_TC * SC_STEP, SC_WAVE_LDS = 8192;
template <int R>
__device__ __forceinline__ void scan_chain(const PP& P, const Ctx& C, int j, int row0, int T, int head, int dir, int lat, int seq, int rowbase, bool write_bon) {
    const bf16* Rb = (const bf16*)(P.ws + B_RKV); const bf16* Kb = Rb + (size_t)M * D; const bf16* Vb = Kb + (size_t)M * D;
    const bf16* DEC = (const bf16*)(P.ws + B_DEC) + (size_t)dir * M * D; const bf16* AA = (const bf16*)(P.ws + B_AA) + (size_t)dir * M * D;
    bf16* Y = (bf16*)(P.ws + B_Y) + (size_t)dir * M * D;   float* BON = (float*)(P.ws + B_BON) + (size_t)dir * M * 32;
    const int lane = C.lane, sts = lane >> 4, sq = lane & 15, rg = lane >> 2, jq = lane & 3, irow = rowbase + R * rg;
    LAS unsigned char* buf = C.lds + C.wave * SC_WAVE_LDS;
    const int ch_off = head * 64 + 4 * sq;
    const f32x4 pkk = *(const f32x4*)(P.in[34] + (size_t)j * D + ch_off), pka = *(const f32x4*)(P.in[35] + (size_t)j * D + ch_off), prk = *(const f32x4*)(P.in[36] + (size_t)j * D + ch_off);
    f32x2 s[R][8];
    if (lat) {
#pragma unroll
        for (int rr = 0; rr < R; ++rr) { const float* s0 = (dir ? P.in[5] : P.in[4]) + ((((size_t)seq * 2 + j) * 32 + head) * 64 + irow + rr) * 64 + jq * 16;
#pragma unroll
            for (int e = 0; e < 4; ++e) { const f32x4 x = *(const f32x4*)(s0 + 4 * e); s[rr][2 * e] = (f32x2){x[0], x[1]}; s[rr][2 * e + 1] = (f32x2){x[2], x[3]}; } }
    } else {
#pragma unroll
        for (int rr = 0; rr < R; ++rr)
#pragma unroll
            for (int e = 0; e < 8; ++e) s[rr][e] = (f32x2){0.f, 0.f};
    }
    struct StageRegs { v2u r, k, v, w, a; size_t row; };
    StageRegs gA, gB;
    const int nch = T / SC_TC;
#define SC_LOAD(g, cc) do { const int t_ = dir == 0 ? SC_TC * (cc) + sts : T - SC_TC * ((cc) + 1) + sts; g.row = (size_t)(row0 + t_); const size_t off_ = ((size_t)head * M + g.row) * 64 + 4 * sq; \
        g.r = *(const v2u*)(Rb + off_); g.k = *(const v2u*)(Kb + off_); g.v = *(const v2u*)(Vb + off_); g.w = *(const v2u*)(DEC + off_); g.a = *(const v2u*)(AA + off_); } while (0)
#define SC_WRITE(g) do { const f32x4 fa_ = (f32x4){(float)(g.a.x & 0xffffu), (float)(g.a.x >> 16), (float)(g.a.y & 0xffffu), (float)(g.a.y >> 16)} * (1.0f / 65535.0f), fw_ = (f32x4){(float)(g.w.x & 0xffffu), (float)(g.w.x >> 16), (float)(g.w.y & 0xffffu), (float)(g.w.y >> 16)} * (0.5f / 65535.0f) + 0.5f; const f32x4 fr_ = (f32x4){bflo(g.r.x), bfhi(g.r.x), bflo(g.r.y), bfhi(g.r.y)}, fk_ = (f32x4){bflo(g.k.x), bfhi(g.k.x), bflo(g.k.y), bfhi(g.k.y)}, fv_ = (f32x4){bflo(g.v.x), bfhi(g.v.x), bflo(g.v.y), bfhi(g.v.y)}; const f32x4 kk = fk_ * pkk; float ss = (kk[0] * kk[0] + kk[1] * kk[1]) + (kk[2] * kk[2] + kk[3] * kk[3]); ss = sum16(ss); \
        const float inv = __builtin_amdgcn_rsqf(fmaxf(ss, 1e-24f)); const f32x4 kn = kk * inv; const f32x4 kd = fk_ * ((fa_ - 1.0f) * pka + 1.0f); \
        const f32x4 rb3 = fr_ * kd * prk; float bs = (rb3[0] + rb3[1]) + (rb3[2] + rb3[3]); bs = sum16(bs); \
        if (write_bon && sq == 0) BON[g.row * 32 + head] = bs; \
        LAS float* d_ = (LAS float*)(buf + sts * SC_STEP) + 4 * sq; \
        *(LAS f32x4*)(d_) = -kn; *(LAS f32x4*)(d_ + 64) = fw_; *(LAS f32x4*)(d_ + 128) = kn * fa_; *(LAS f32x4*)(d_ + 192) = kd; *(LAS f32x4*)(d_ + 256) = fr_; *(LAS f32x4*)(d_ + 320) = fv_; } while (0)
    bf16* yb = Y + (size_t)head * M * 64 + irow;
    auto compute_chunk = [&](int cc) __attribute__((always_inline)) {
        const int tbase = dir == 0 ? SC_TC * cc : T - SC_TC * (cc + 1);
        f32x4 xan[4];
        asm volatile("s_waitcnt lgkmcnt(2)" ::: "memory");
        { const LAS float* vp0 = (const LAS float*)(buf + (dir == 0 ? 0 : SC_TC - 1) * SC_STEP) + jq * 16;
#pragma unroll
          for (int e = 0; e < 4; ++e) xan[e] = *(const LAS f32x4*)(vp0 + 4 * e); }
#pragma unroll 2
        for (int st = 0; st < SC_TC; ++st) {
            const int ts = dir == 0 ? st : SC_TC - 1 - st;
            const LAS float* vp = (const LAS float*)(buf + ts * SC_STEP) + jq * 16;
            f32x2 a[8], w[8], b[8], k[8], r[8];
#pragma unroll
            for (int e = 0; e < 4; ++e) { a[2 * e] = (f32x2){xan[e][0], xan[e][1]}; a[2 * e + 1] = (f32x2){xan[e][2], xan[e][3]}; }
#pragma unroll
            for (int e = 0; e < 4; ++e) { const f32x4 xw = *(const LAS f32x4*)(vp + 64 + 4 * e), xb = *(const LAS f32x4*)(vp + 128 + 4 * e);
                w[2 * e] = (f32x2){xw[0], xw[1]}; w[2 * e + 1] = (f32x2){xw[2], xw[3]}; b[2 * e] = (f32x2){xb[0], xb[1]}; b[2 * e + 1] = (f32x2){xb[2], xb[3]}; }
            float vi[R];
            { const LAS float* vv = (const LAS float*)(buf + ts * SC_STEP) + 320 + irow;
              if (R == 4) { const f32x4 x = *(const LAS f32x4*)vv; vi[0] = x[0]; vi[1] = x[1]; vi[R - 2] = x[2]; vi[R - 1] = x[3]; }
              else { const f32x2 x = *(const LAS f32x2*)vv; vi[0] = x[0]; vi[1] = x[1]; } }
            float sa_[R];
#pragma unroll
            for (int rr = 0; rr < R; ++rr) {
                f32x2 sa2 = s[rr][0] * a[0], sa3 = s[rr][1] * a[1];
#pragma unroll
                for (int e = 2; e < 8; e += 2) { sa2 = s[rr][e] * a[e] + sa2; sa3 = s[rr][e + 1] * a[e + 1] + sa3; }
                sa2 = sa2 + sa3;
                sa_[rr] = quad_sum(sa2[0] + sa2[1]);
            }
            if (R == 4) asm volatile("s_waitcnt lgkmcnt(2)" : "+v"(sa_[0]), "+v"(sa_[1]), "+v"(sa_[R - 2]), "+v"(sa_[R - 1]) :: "memory");
            else asm volatile("s_waitcnt lgkmcnt(2)" : "+v"(sa_[0]), "+v"(sa_[1]) :: "memory");
#pragma unroll
            for (int e = 0; e < 4; ++e) { const f32x4 xk = *(const LAS f32x4*)(vp + 192 + 4 * e), xr = *(const LAS f32x4*)(vp + 256 + 4 * e);
                k[2 * e] = (f32x2){xk[0], xk[1]}; k[2 * e + 1] = (f32x2){xk[2], xk[3]}; r[2 * e] = (f32x2){xr[0], xr[1]}; r[2 * e + 1] = (f32x2){xr[2], xr[3]}; }
            if (st + 1 < SC_TC) { const LAS float* vpn = (const LAS float*)(buf + (dir == 0 ? st + 1 : SC_TC - 2 - st) * SC_STEP) + jq * 16;
#pragma unroll
                for (int e = 0; e < 4; ++e) xan[e] = *(const LAS f32x4*)(vpn + 4 * e); }
            float yo[R];
#pragma unroll
            for (int rr = 0; rr < R; ++rr) {
                const f32x2 sav = (f32x2){sa_[rr], sa_[rr]};
#pragma unroll
                for (int e = 0; e < 8; ++e) s[rr][e] = s[rr][e] * w[e] + b[e] * sav;
            }
#pragma unroll
            for (int rr = 0; rr < R; ++rr) {
                const f32x2 vv2 = (f32x2){vi[rr], vi[rr]};
                f32x2 y2 = (f32x2){0.f, 0.f}, y3 = (f32x2){0.f, 0.f};
#pragma unroll
                for (int e = 0; e < 8; e += 2) { s[rr][e] = k[e] * vv2 + s[rr][e]; s[rr][e + 1] = k[e + 1] * vv2 + s[rr][e + 1];
                    y2 = s[rr][e] * r[e] + y2; y3 = s[rr][e + 1] * r[e + 1] + y3; }
                y2 = y2 + y3;
                yo[rr] = quad_sum(y2[0] + y2[1]);
            }
            if (jq == 0) { bf16* yp = yb + (size_t)(row0 + tbase + ts) * 64;
                if (R == 4) { v2u w; w.x = pg8::cvt_pk_bf16(yo[0], yo[1]); w.y = pg8::cvt_pk_bf16(yo[R - 2], yo[R - 1]); *(v2u*)yp = w; } else *(unsigned*)yp = pg8::cvt_pk_bf16(yo[0], yo[1]); }
        }
    };
    SC_LOAD(gA, 0); SC_WRITE(gA);
    SC_LOAD(gA, 1);
#pragma unroll 1
    for (int cc = 0; cc < nch; cc += 2) {
        if (cc + 2 < nch) SC_LOAD(gB, cc + 2);
        compute_chunk(cc);
        SC_WRITE(gA);
        if (cc + 3 < nch) SC_LOAD(gA, cc + 3);
        compute_chunk(cc + 1);
        if (cc + 2 < nch) SC_WRITE(gB);
    }
#undef SC_LOAD
#undef SC_WRITE
    if (!lat) {
#pragma unroll
        for (int rr = 0; rr < R; ++rr) { float* so = P.out + (dir ? O_SB : O_SF) + ((((size_t)seq * 2 + j) * 32 + head) * 64 + irow + rr) * 64 + jq * 16;
#pragma unroll
            for (int e = 0; e < 4; ++e) *(f32x4*)(so + 4 * e) = (f32x4){s[rr][2 * e][0], s[rr][2 * e][1], s[rr][2 * e + 1][0], s[rr][2 * e + 1][1]}; }
    }
}
__device__ __forceinline__ void phase_scan(const PP& P, const Ctx& C, int j, int late_set) {
    for (int vc = C.vcu; vc < 256; vc += C.G) {
        if (C.wave < 2) {
            __builtin_amdgcn_s_setprio(2);
            scan_chain<2>(P, C, j, MP + (vc >> 6) * 1024, 1024, (vc >> 1) & 31, vc & 1, 1, vc >> 6, 32 * C.wave, C.wave == 0);
            __builtin_amdgcn_s_setprio(0);
        } else {
            const int m0 = C.wave < 4 ? 2 * (C.wave - 2) : C.wave, nm = C.wave < 4 ? 2 : 1;
#pragma unroll 1
            for (int q = 0; q < nm; ++q) { const int cidx = 8 * vc + m0 + q; scan_chain<4>(P, C, j, (cidx >> 6) * 256, 256, (cidx >> 1) & 31, cidx & 1, 0, cidx >> 6, 0, true); }
        }
    }
    if (late_set >= 0 && C.wave >= 4) {
        LAS float* scr = (LAS float*)(C.lds + 65536 + (C.wave - 4) * 16640);
        const int nlw = C.G * 4;
        const int nlate = late_set == 0 ? IT_LATE_A : IT_LATE_B;
        for (int t = C.vcu * 4 + (C.wave - 4); t < nlate; t += nlw) { TJob J; int item; make_job(P, late_item(t, late_set), J, item); transpose_item(J, item, scr, C.lane); }
    }
}
__device__ __forceinline__ void phase_post(const PP& P, const Ctx& C, int j) {
    const bf16* Y = (const bf16*)(P.ws + B_Y); const float* BON = (const float*)(P.ws + B_BON); const bf16* Vb = (const bf16*)(P.ws + B_RKV) + (size_t)2 * M * D; const bf16* G = (const bf16*)(P.ws + B_G);
    bf16* O2 = (bf16*)(P.ws + B_O2);
    const float* lnw = P.in[37] + (size_t)j * D; const float* lnb = P.in[38] + (size_t)j * D;
    const int hs = C.lane >> 4, q = C.lane & 15;
    for (int r = C.gw; r < M; r += C.ngw) {
        f32x4 yf[8], yb[8], vv[8], gg[8]; float b0[8], b1[8];
#pragma unroll
        for (int p = 0; p < 8; ++p) { const int head = p * 4 + hs; const size_t off = (size_t)r * D + head * 64 + 4 * q;
            const size_t hoff = ((size_t)head * M + r) * 64 + 4 * q;
            { const v2u a_ = *(const v2u*)(Y + hoff), b_ = *(const v2u*)(Y + (size_t)M * D + hoff); yf[p] = (f32x4){bflo(a_.x), bfhi(a_.x), bflo(a_.y), bfhi(a_.y)}; yb[p] = (f32x4){bflo(b_.x), bfhi(b_.x), bflo(b_.y), bfhi(b_.y)}; } { const v2u v_ = *(const v2u*)(Vb + hoff); vv[p] = (f32x4){bflo(v_.x), bfhi(v_.x), bflo(v_.y), bfhi(v_.y)}; } { const v2u gw_ = *(const v2u*)(G + off); gg[p] = (f32x4){bflo(gw_.x), bfhi(gw_.x), bflo(gw_.y), bfhi(gw_.y)}; }
            b0[p] = BON[(size_t)r * 32 + head]; b1[p] = BON[((size_t)M + r) * 32 + head]; }
#pragma unroll
        for (int p = 0; p < 8; ++p) { const int head = p * 4 + hs, c = head * 64 + 4 * q; const size_t off = (size_t)r * D + c;
            const f32x4 y = yf[p] + yb[p];
            const float mean = sum16((y[0] + y[1]) + (y[2] + y[3])) * (1.0f / 64);
            const f32x4 d = y - mean;
            const float var = sum16((d[0] * d[0] + d[1] * d[1]) + (d[2] * d[2] + d[3] * d[3])) * (1.0f / 64);
            const float rs = __builtin_amdgcn_rsqf(var + GN_EPS);
            const f32x4 o = (d * rs * *(const f32x4*)(lnw + c) + *(const f32x4*)(lnb + c) + vv[p] * (b0[p] + b1[p])) * gg[p];
            v2u w; w.x = pk2(o[0], o[1]); w.y = pk2(o[2], o[3]); *(v2u*)(O2 + off) = w; }
    }
}

__device__ __forceinline__ Ctx make_ctx(LAS unsigned char* lds, int wave0) {
    Ctx C; C.lds = lds; C.lane = pg8::lane_id_v(); C.wave = wave0; C.tid = C.wave * 64 + C.lane;
    const int bx = opaque_s((int)blockIdx.x); C.G = opaque_s((int)gridDim.x); C.vcu = (C.G % 8 == 0) ? (bx % 8) * (C.G / 8) + bx / 8 : bx;
    C.gw = C.vcu * NWAVES + C.wave; C.ngw = C.G * NWAVES; return C;
}
__global__ void __launch_bounds__(NTHR, 2) fwd_kernel(Params K) {
    extern __shared__ __attribute__((aligned(16))) unsigned char lds_raw[];
    LAS unsigned char* const lds0 = (LAS unsigned char*)lds_raw;
    volatile LAS unsigned* MISC = (volatile LAS unsigned*)(lds0 + MISC_OFF);
    if (threadIdx.x < 64) MISC[threadIdx.x] = 0u;
    __syncthreads();
    (void)xcd_barrier_post((unsigned*)(K.ws + WS_CTL) + CW_BAR, MISC + 8);
    const int wave0 = __builtin_amdgcn_readfirstlane((int)threadIdx.x >> 6);
    const int lo = K.ph_lo, hi = K.ph_hi; int pidx = 0;
#ifndef PHMASK
#define PHMASK 0xFFFFFFFFu
#endif
#define EN(n) (((PHMASK) >> (n)) & 1u)
#ifndef DUPMASK
#define DUPMASK 0u
#endif
#define NREP(n) ((((DUPMASK) >> (n)) & 1u) ? 2 : 1)
#define PH_BEGIN(n) if (EN(n) && lo <= pidx && pidx < hi) { for (int rep_ = 0; rep_ < NREP(n); ++rep_) { const bool dup_first = NREP(n) > 1 && opaque_s(rep_) == 0; (void)dup_first; const PP P = make_pp(); const Ctx C = make_ctx(lds0, wave0); unsigned char* const ws = P.ws; float* const modb = (float*)(ws + WS_MOD); bf16* const X = (bf16*)(ws + WS_X); (void)modb; (void)X; (void)C;
#define PH_END if (pidx + 1 < hi || dup_first) { XcdBarrier b_; b_.bar = (unsigned*)(ws + WS_CTL) + CW_BAR; b_.x = xb_xcc_id(); b_.lead = (wave0 == 0 && pg8::lane_id_v() == 0) ? 1u : 0u; b_.st = (volatile LAS unsigned*)(lds0 + MISC_OFF) + 8; xcd_barrier(b_); } } } ++pidx;

    PH_BEGIN(0) p0_prologue(P, C); PH_END

    for (int l = 0; l < 4; ++l) {
        const int j = l >> 1;
        for (int half = 0; half < 2; ++half) {
            PH_BEGIN(1) phase_norm(P, C, l, half * 2); PH_END
            PH_BEGIN(2) { const char* A_ = (const char*)(ws + WS_H); const char* B_ = (const char*)(ws + WS_WFI) + (size_t)(l * 2 + half) * NFI * D * 2;
                { pg8::SchedFa S; S.A = A_; S.B = B_; S.G = C.G; S.c = opaque_s((int)blockIdx.x); S.tstep = (size_t)256 * D * 2;
                  pg8::EpiSwigluT<4> E{(bf16*)(ws + WS_U)};
                  pg8::gemm_phase<pg8::EpiSwigluT<4>, pg8::SchedFa, true, true, 4>(C.lds, D, S, E, C.tid); }
                { pg8::SchedFb S; S.A = A_; S.B = B_; S.G = C.G; S.c = opaque_s((int)blockIdx.x); S.tstep = (size_t)256 * D * 2;
                  pg8::EpiSwigluT<1> E{(bf16*)(ws + WS_U)};
                  pg8::gemm_phase<pg8::EpiSwigluT<1>, pg8::SchedFb, true, true, 1>(C.lds, D, S, E, C.tid); } } PH_END
            PH_BEGIN(3) { pg8::Sched1 S; S.A = (const char*)(ws + WS_U); S.B = (const char*)(ws + WS_WFO) + (size_t)(l * 2 + half) * D * DFF * 2; S.nM = M / 192; S.nN = D / 256; S.G = C.G; S.c = opaque_s((int)blockIdx.x); S.tstep = (size_t)192 * DFF * 2; S.tstepB = (size_t)256 * DFF * 2;
                pg8::EpiResidT<3> E{X, modb + (size_t)l * 5 * 18432 + (half ? 8 : 2) * D, dup_first ? 0.f : 0.5f};
                pg8::gemm_phase<pg8::EpiResidT<3>, pg8::Sched1, true, true, 3>(C.lds, DFF, S, E, C.tid); } PH_END
            if (half == 0) {
                PH_BEGIN(1) phase_norm(P, C, l, 1); PH_END
                if ((l & 1) == 0) {
#define wb (ws + WS_WMLA + (size_t)j * 20 * MiB)
                    PH_BEGIN(4) { pg8::Sched1 S; S.A = (const char*)(ws + WS_H); S.B = (const char*)wb; S.nM = M / 256; S.nN = 5; S.G = C.G; S.c = opaque_s((int)blockIdx.x); S.tstep = (size_t)256 * D * 2; S.tstepB = S.tstep;
                        pg8::EpiF32 E{(float*)(ws + A_RAW), 1280};
                        pg8::gemm_phase<pg8::EpiF32, pg8::Sched1, true, true>(C.lds, D, S, E, C.tid); } PH_END
                    PH_BEGIN(5) phase_mla_norm(P, C, j); PH_END
                    PH_BEGIN(6) { pg8::SchedM3 S; S.A0 = (const char*)(ws + A_CQ); S.B0 = (const char*)(wb + 5 * MiB); S.A1 = (const char*)(ws + A_CKV); S.B1 = (const char*)(wb + 8 * MiB);
                        S.nM0 = M / 256; S.nN0 = 12; S.nM1 = KVROWS / 256; S.nN1 = 16; S.G = C.G; S.c = opaque_s((int)blockIdx.x); S.tstep = (size_t)256 * 512 * 2;
                        pg8::EpiM3 E{(bf16*)(ws + A_Q), (bf16*)(ws + A_KV)};
                        pg8::gemm_phase<pg8::EpiM3, pg8::SchedM3, true, true>(C.lds, 512, S, E, C.tid); } PH_END
                    PH_BEGIN(8) phase_attn(P, C); PH_END
                    PH_BEGIN(9) { pg8::Sched1 S; S.A = (const char*)(ws + A_O); S.B = (const char*)(wb + 12 * MiB); S.nM = M / 192; S.nN = D / 256; S.G = C.G; S.c = opaque_s((int)blockIdx.x); S.tstep = (size_t)192 * D * 2; S.tstepB = (size_t)256 * D * 2;
                        pg8::EpiResidT<3> E{X, modb + (size_t)l * 5 * 18432 + 5 * D, dup_first ? 0.f : 1.0f};
                        pg8::gemm_phase<pg8::EpiResidT<3>, pg8::Sched1, true, true, 3>(C.lds, D, S, E, C.tid); } PH_END
                } else {
#undef wb
#define wb (ws + WS_WRW + (size_t)j * 42 * MiB)
                    PH_BEGIN(10) phase_shift(P, C, j); PH_END
                    PH_BEGIN(11) { pg8::SchedR2 S; S.A = (const char*)(ws + B_XMIX); S.B = (const char*)wb; S.nM = M / 256; S.G = C.G; S.c = opaque_s((int)blockIdx.x); S.tstep = (size_t)256 * D * 2; S.astride = (size_t)M * D * 2;
                        pg8::EpiR2 E{(bf16*)(ws + B_RKV), (size_t)M * D, (bf16*)(ws + B_T1), (size_t)M * 256, (size_t)M};
                        pg8::gemm_phase<pg8::EpiR2, pg8::SchedR2, true, true>(C.lds, D, S, E, C.tid); } PH_END
                    PH_BEGIN(12) { pg8::SchedR3 S; S.A = (const char*)(ws + B_T1); S.B = (const char*)(wb + 29 * MiB); S.nM = M / 256; S.G = C.G; S.c = opaque_s((int)blockIdx.x); S.tstep = (size_t)256 * 256 * 2; S.astride = (size_t)M * 256 * 2;
                        pg8::EpiR3 E{(bf16*)(ws + B_G), (bf16*)(ws + B_DEC), (bf16*)(ws + B_AA), (size_t)M * D, P.in[26] + (size_t)j * 2 * D, P.in[29] + (size_t)j * 2 * D, (size_t)M};
                        pg8::gemm_phase<pg8::EpiR3, pg8::SchedR3, true, true>(C.lds, 256, S, E, C.tid); } PH_END
                    PH_BEGIN(13) phase_scan(P, C, j, dup_first ? -1 : (l == 1 ? 0 : 1)); PH_END
                    PH_BEGIN(14) phase_post(P, C, j); PH_END
                    PH_BEGIN(15) { pg8::Sched1 S; S.A = (const char*)(ws + B_O2); S.B = (const char*)(wb + 34 * MiB); S.nM = M / 192; S.nN = D / 256; S.G = C.G; S.c = opaque_s((int)blockIdx.x); S.tstep = (size_t)192 * D * 2; S.tstepB = (size_t)256 * D * 2;
                        pg8::EpiResidT<3> E{X, modb + (size_t)l * 5 * 18432 + 5 * D, dup_first ? 0.f : 1.0f};
                        pg8::gemm_phase<pg8::EpiResidT<3>, pg8::Sched1, true, true, 3>(C.lds, D, S, E, C.tid); } PH_END
                }
            }
        }
    }
    PH_BEGIN(16) phase_final(P, C); PH_END
#undef PH_BEGIN
#undef wb
#undef PH_END
}

#ifndef MK_PER_PHASE
#define MK_PER_PHASE 0
#endif
constexpr int N_PHASES = 52;
extern "C" void kernel_launch(void* const* d_in, const int* in_sizes, int n_in, void* d_out, int out_size, void* d_ws, size_t ws_size, hipStream_t stream) {
    static int grid = 0;
    if (grid == 0) {
        if (n_in != 40 || out_size != (int)O_END || ws_size < WS_END) { fprintf(stderr, "kernel_launch: unexpected problem (n_in %d, out %d, ws %zu; need ws >= %zu); nothing launched\n", n_in, out_size, ws_size, (size_t)WS_END); grid = -1; return; }
        int dev = 0, cus = 0, per_cu = 0;
        if (hipGetDevice(&dev) != hipSuccess || hipDeviceGetAttribute(&cus, hipDeviceAttributeMultiprocessorCount, dev) != hipSuccess) { grid = -1; return; }
        if (hipFuncSetAttribute((const void*)fwd_kernel, hipFuncAttributeMaxDynamicSharedMemorySize, LDS_BYTES) != hipSuccess) { fprintf(stderr, "kernel_launch: hipFuncSetAttribute failed\n"); grid = -1; return; }
        if (hipOccupancyMaxActiveBlocksPerMultiprocessor(&per_cu, (const void*)fwd_kernel, NTHR, LDS_BYTES) != hipSuccess || per_cu < 1) { fprintf(stderr, "kernel_launch: occupancy query says %d\n", per_cu); }
        (void)hipGetLastError();
        grid = cus > 256 ? 256 : cus;
    }
    if (grid < 0) return;
    (void)hipMemsetAsync((char*)d_ws + WS_CTL, 0, CTL_ZERO_BYTES, stream);
    Params p{};
    for (int i = 0; i < 40; ++i) p.in[i] = (const float*)d_in[i];
    p.out = (float*)d_out; p.ws = (unsigned char*)d_ws;
#if MK_PER_PHASE
    for (int li = 0; li < N_PHASES; ++li) { p.ph_lo = li; p.ph_hi = li + 1; hipLaunchKernelGGL(fwd_kernel, dim3(grid), dim3(NTHR), LDS_BYTES, stream, p); }
#else
    p.ph_lo = 0; p.ph_hi = N_PHASES;
    hipLaunchKernelGGL(fwd_kernel, dim3(grid), dim3(NTHR), LDS_BYTES, stream, p);
#endif
}
```

```cpp
#include <hip/hip_runtime.h>
#include <cstdio>
#include <cstdint>
namespace pg8 {
#define PG8_LAS __attribute__((address_space(3)))
typedef unsigned short bf16_t;
typedef short bf16x8 __attribute__((ext_vector_type(8)));
typedef float f32x4 __attribute__((ext_vector_type(4)));
typedef unsigned u32x4 __attribute__((ext_vector_type(4)));
constexpr int BM = 256, BK = 64, HALF = 128, HTB = HALF * BK * 2  , STAGE_BYTES = 8 * HTB, NXCD = 8, WGM = 8;

__host__ __device__ __forceinline__ int lds_byte(int r, int c) { const int st = (r >> 4) * 2 + (c >> 5), rr = r & 15, cc = c & 31, ob = rr * 64 + cc * 2; return st * 1024 + (ob ^ (((ob >> 9) & 1) << 5)); }
__host__ __device__ __forceinline__ void stage_rc(int b, int& R, int& C) { const int st = b / 1024, sb = b % 1024, swz = sb ^ (((sb >> 9) & 1) << 5); R = (st >> 1) * 16 + swz / 64; C = (st & 1) * 32 + (swz % 64) / 2; }
__host__ __device__ __forceinline__ int perm32(int rho) { const int n = rho >> 4, i = rho & 15; return 8 * (i >> 2) + 4 * n + (i & 3); }

struct Unit { int pm, pn, g; };

__device__ __forceinline__ void tile_of(int L, int nM, int nN, int& pm, int& pn) {
    const int nwg = nM * nN; int wgid = L; { const int q = nwg / NXCD, r = nwg % NXCD, xcd = wgid % NXCD, off = wgid / NXCD; wgid = (xcd < r ? xcd * (q + 1) : r * (q + 1) + (xcd - r) * q) + off; }
    const int nig = WGM * nN, gid = wgid / nig, fm = gid * WGM, gsz = (nM - fm) < WGM ? (nM - fm) : WGM;
    pm = fm + ((wgid % nig) % gsz); pn = (wgid % nig) / gsz;
}
__device__ __forceinline__ int opaque_v(int x) { asm volatile("" : "+v"(x)); return x; }
__device__ __forceinline__ int opaque_s(int x) { asm volatile("" : "+v"(x)); return __builtin_amdgcn_readfirstlane(x); }
__device__ __forceinline__ int lane_id_v() { int l; asm volatile("v_mbcnt_lo_u32_b32 %0, -1, 0\n\tv_mbcnt_hi_u32_b32 %0, -1, %0" : "=v"(l)); return l; }
template <class Epi, class Sched, bool ALIGN_EPI = false, bool SP2 = false, int MB = 4>
__device__ __forceinline__ void gemm_phase(PG8_LAS unsigned char* lds, const int K, const Sched& S, const Epi& E, const int tid_in) {
    const int tid = opaque_v(tid_in), wid = __builtin_amdgcn_readfirstlane(tid >> 6), lane = tid & 63, wr = wid >> 2, wc = wid & 3, fr = lane & 15, fq = lane >> 4;
    const int nt = K / BK;
    unsigned voffA[2], voffB[2];
#pragma unroll
    for (int i = 0; i < 2; ++i) { int R, C; stage_rc(tid * 16 + i * 8192, R, C); const int Rb = Epi::PERM ? ((R & ~31) + perm32(R & 31)) : R;
        const int mR = (R >> 4) & 3, Ra = MB == 4 ? R : (R >> 6) * (16 * MB) + (mR < MB ? mR : MB - 1) * 16 + (R & 15);
        voffA[i] = (unsigned)(Ra * K + C) * 2u; voffB[i] = (unsigned)(Rb * K + C) * 2u; }
    const size_t kstep = (size_t)(BK * 2);
    const size_t hstep = (size_t)HALF * K * 2;
    const size_t hstepA = (size_t)(32 * MB) * K * 2;
    const unsigned ldsw = (unsigned)wid * 1024u;
    const int aoff = lds_byte(wr * 64 + fr, fq * 8), boff = lds_byte(wc * 32 + fr, fq * 8);
#define PG8_SA(b, h) (((b) * 2 + (h)) * HTB)
#define PG8_SB(b, h) ((4 + (b) * 2 + (h)) * HTB)
#define PG8_STAGE(bufoff, gbase, voff) do { _Pragma("unroll") for (int _i = 0; _i < 2; ++_i) \
        __builtin_amdgcn_global_load_lds((const unsigned*)((const char*)(gbase) + (voff)[_i]), (PG8_LAS unsigned*)(lds + (bufoff) + ldsw + _i * 8192), 16, 0, 0); } while (0)
#define PG8_LDA(dst, b, h) do { _Pragma("unroll") for (int m = 0; m < MB; ++m) _Pragma("unroll") for (int k = 0; k < 2; ++k) dst[m][k] = *(const PG8_LAS bf16x8*)(lds + PG8_SA(b, h) + aoff + m * 2048 + k * 1024); } while (0)
#define PG8_LDB(dst, b, h) do { _Pragma("unroll") for (int n = 0; n < 2; ++n) _Pragma("unroll") for (int k = 0; k < 2; ++k) dst[n][k] = *(const PG8_LAS bf16x8*)(lds + PG8_SB(b, h) + boff + n * 2048 + k * 1024); } while (0)
#define PG8_MMA(ai, bj, At, Bt) do { __builtin_amdgcn_s_setprio(1); _Pragma("unroll") for (int m = 0; m < MB; ++m) _Pragma("unroll") for (int n = 0; n < 2; ++n) _Pragma("unroll") for (int k = 0; k < 2; ++k) \
        acc[ai][bj][m][n] = __builtin_amdgcn_mfma_f32_16x16x32_bf16(Bt[n][k], At[m][k], acc[ai][bj][m][n], 0, 0, 0); __builtin_amdgcn_s_setprio(0); } while (0)
#define PG8_WAIT_V(n) asm volatile("s_waitcnt vmcnt(" #n ")" ::: "memory")
#define PG8_WAIT_L(n) asm volatile("s_waitcnt lgkmcnt(" #n ")" ::: "memory")
#define PG8_BAR __builtin_amdgcn_s_barrier()
#define PG8_SCHED __builtin_amdgcn_sched_barrier(0)
    Unit cur, nxt; int ui = 0;
    if (!S.next(0, cur)) return;
    f32x4 acc[2][2][MB][2];
#pragma unroll
    for (int a = 0; a < 2; ++a)
#pragma unroll
        for (int b = 0; b < 2; ++b)
#pragma unroll
            for (int m = 0; m < MB; ++m)
#pragma unroll
                for (int n = 0; n < 2; ++n) acc[a][b][m][n] = (f32x4){0.f, 0.f, 0.f, 0.f};
    bf16x8 At[MB][2], B0[2][2], B1[2][2];
    const char* cA = S.a_ptr(cur); const char* cB = S.b_ptr(cur);
    S.a_ready(cur);
    if constexpr (SP2) {
        PG8_STAGE(PG8_SB(0, 0), cB, voffB); PG8_STAGE(PG8_SB(0, 1), cB + hstep, voffB); PG8_STAGE(PG8_SA(0, 0), cA, voffA); PG8_STAGE(PG8_SA(0, 1), cA + hstepA, voffA);
        if (wr == 1) PG8_BAR;
        PG8_WAIT_V(2); PG8_BAR;
        PG8_STAGE(PG8_SB(1, 0), cB + kstep, voffB); PG8_STAGE(PG8_SA(1, 0), cA + kstep, voffA); PG8_STAGE(PG8_SB(1, 1), cB + hstep + kstep, voffB);
        PG8_WAIT_V(6); PG8_BAR;
    } else {
        PG8_STAGE(PG8_SB(0, 0), cB, voffB); PG8_STAGE(PG8_SA(0, 0), cA, voffA); PG8_STAGE(PG8_SB(0, 1), cB + hstep, voffB); PG8_STAGE(PG8_SA(0, 1), cA + hstepA, voffA);
        if (wr == 1) PG8_BAR;
        PG8_WAIT_V(4); PG8_BAR;
        PG8_STAGE(PG8_SB(1, 0), cB + kstep, voffB); PG8_STAGE(PG8_SA(1, 0), cA + kstep, voffA); PG8_STAGE(PG8_SB(1, 1), cB + hstep + kstep, voffB);
        PG8_WAIT_V(6); PG8_BAR;
    }
    for (;;) {
        const bool has_next = S.next(ui + 1, nxt);
        const char* nA = has_next ? S.a_ptr(nxt) : cA; const char* nB = has_next ? S.b_ptr(nxt) : cB;
        for (int t = 0; t < nt; t += 2) {
            const bool last = (t == nt - 2);
            const char* a1 = cA + (size_t)(t + 1) * kstep;
            const char* a2 = last ? nA : cA + (size_t)(t + 2) * kstep; const char* b2 = last ? nB : cB + (size_t)(t + 2) * kstep;
            const char* a3 = a2 + kstep; const char* b3 = b2 + kstep;
            if (last && has_next) S.a_ready(nxt);
            if constexpr (SP2) {
            PG8_LDB(B0, 0, 0); PG8_LDB(B1, 0, 1); PG8_SCHED; PG8_LDA(At, 0, 0); PG8_STAGE(PG8_SA(1, 1), a1 + hstepA, voffA);
            PG8_WAIT_V(8); PG8_WAIT_L(0); PG8_BAR; PG8_MMA(0, 0, At, B0); PG8_MMA(0, 1, At, B1); PG8_BAR; PG8_SCHED;
            PG8_LDA(At, 0, 1); PG8_STAGE(PG8_SB(0, 0), b2, voffB); PG8_STAGE(PG8_SB(0, 1), b2 + hstep, voffB); PG8_STAGE(PG8_SA(0, 0), a2, voffA);
            PG8_WAIT_V(8); PG8_WAIT_L(0); PG8_BAR; PG8_MMA(1, 0, At, B0); PG8_MMA(1, 1, At, B1); PG8_BAR; PG8_SCHED;
            PG8_LDB(B0, 1, 0); PG8_LDB(B1, 1, 1); PG8_SCHED; PG8_LDA(At, 1, 0); PG8_STAGE(PG8_SA(0, 1), a2 + hstepA, voffA);
            PG8_WAIT_V(8); PG8_WAIT_L(0); PG8_BAR; PG8_MMA(0, 0, At, B0); PG8_MMA(0, 1, At, B1); PG8_BAR; PG8_SCHED;
            PG8_LDA(At, 1, 1); PG8_STAGE(PG8_SB(1, 0), b3, voffB); PG8_STAGE(PG8_SB(1, 1), b3 + hstep, voffB); PG8_STAGE(PG8_SA(1, 0), a3, voffA);
            PG8_WAIT_V(8); PG8_WAIT_L(0); PG8_BAR; PG8_MMA(1, 0, At, B0); PG8_MMA(1, 1, At, B1); PG8_BAR; PG8_SCHED;
            } else {
            PG8_LDB(B0, 0, 0); PG8_SCHED; PG8_LDA(At, 0, 0); PG8_STAGE(PG8_SA(1, 1), a1 + hstepA, voffA);
            PG8_WAIT_L(8); PG8_BAR; PG8_WAIT_L(0); PG8_MMA(0, 0, At, B0); PG8_BAR; PG8_SCHED;
            PG8_LDB(B1, 0, 1); PG8_STAGE(PG8_SB(0, 0), b2, voffB);
            PG8_BAR; PG8_WAIT_L(0); PG8_MMA(0, 1, At, B1); PG8_BAR;
            PG8_LDA(At, 0, 1); PG8_STAGE(PG8_SA(0, 0), a2, voffA);
            PG8_BAR; PG8_WAIT_L(0); PG8_MMA(1, 0, At, B0); PG8_BAR; PG8_SCHED;
            PG8_STAGE(PG8_SB(0, 1), b2 + hstep, voffB);
            PG8_WAIT_V(6); PG8_BAR; PG8_MMA(1, 1, At, B1); PG8_BAR;
            PG8_LDB(B0, 1, 0); PG8_SCHED; PG8_LDA(At, 1, 0); PG8_STAGE(PG8_SA(0, 1), a2 + hstepA, voffA);
            PG8_WAIT_L(8); PG8_BAR; PG8_WAIT_L(0); PG8_MMA(0, 0, At, B0); PG8_BAR; PG8_SCHED;
            PG8_LDB(B1, 1, 1); PG8_STAGE(PG8_SB(1, 0), b3, voffB);
            PG8_BAR; PG8_WAIT_L(0); PG8_MMA(0, 1, At, B1); PG8_BAR;
            PG8_LDA(At, 1, 1); PG8_STAGE(PG8_SA(1, 0), a3, voffA);
            PG8_BAR; PG8_WAIT_L(0); PG8_MMA(1, 0, At, B0); PG8_BAR; PG8_SCHED;
            PG8_STAGE(PG8_SB(1, 1), b3 + hstep, voffB);
            PG8_WAIT_V(6); PG8_BAR; PG8_MMA(1, 1, At, B1); PG8_BAR;
            }
        }
        if constexpr (ALIGN_EPI) { if (wr == 0) PG8_BAR; }
        if constexpr (!Epi::AFTER_DRAIN) { E(acc, cur, wr, wc, fr, fq); S.done(cur); }
        if (!has_next) break;
#pragma unroll
        for (int a = 0; a < 2; ++a)
#pragma unroll
            for (int b = 0; b < 2; ++b)
#pragma unroll
                for (int m = 0; m < MB; ++m)
#pragma unroll
                    for (int n = 0; n < 2; ++n) acc[a][b][m][n] = (f32x4){0.f, 0.f, 0.f, 0.f};
        cur = nxt; cA = nA; cB = nB; ++ui;
        if constexpr (ALIGN_EPI) { if (wr == 1) PG8_BAR; }
    }
    PG8_WAIT_V(0);
    if constexpr (!ALIGN_EPI) { if (wr == 0) PG8_BAR; }
    PG8_BAR;
    if constexpr (Epi::AFTER_DRAIN) { E.fused(acc, cur, wr, wc, fr, fq, lds, wid, lane); S.done(cur); }
#undef PG8_SA
#undef PG8_SB
#undef PG8_STAGE
#undef PG8_LDA
#undef PG8_LDB
#undef PG8_MMA
#undef PG8_WAIT_V
#undef PG8_WAIT_L
#undef PG8_BAR
#undef PG8_SCHED
}

struct SchedBase { __device__ __forceinline__ void a_ready(const Unit&) const {} __device__ __forceinline__ void done(const Unit&) const {} };
struct Sched1 : SchedBase {
    const char* A; const char* B; int nM, nN, G, c; size_t tstep, tstepB;
    __device__ __forceinline__ bool next(int i, Unit& u) const { const long L = (long)i * G + c; if (L >= (long)nM * nN) return false; tile_of((int)L, nM, nN, u.pm, u.pn); u.g = 0; return true; }
    __device__ __forceinline__ const char* a_ptr(const Unit& u) const { return A + (size_t)u.pm * tstep; }
    __device__ __forceinline__ const char* b_ptr(const Unit& u) const { return B + (size_t)u.pn * tstepB; }
};
struct SchedFa : SchedBase {
    const char* A; const char* B; int G, c; size_t tstep;
    __device__ __forceinline__ bool next(int i, Unit& u) const { const long L = (long)i * G + c; if (L >= 2048) return false; if (L < 2024) tile_of((int)L, 46, 44, u.pm, u.pn); else { u.pm = 46; u.pn = (int)L - 2024; } u.g = 0; return true; }
    __device__ __forceinline__ const char* a_ptr(const Unit& u) const { return A + (size_t)u.pm * tstep; }
    __device__ __forceinline__ const char* b_ptr(const Unit& u) const { return B + (size_t)u.pn * tstep; }
};
struct SchedFb : SchedBase {
    const char* A; const char* B; int G, c; size_t tstep;
    __device__ __forceinline__ bool next(int i, Unit& u) const { const long L0 = (long)i * G + c; if (L0 >= 256) return false;
        const int L = ((int)L0 & 7) * 32 + ((int)L0 >> 3);
        if (L < 80) { u.pn = 24 + (L >> 2); u.pm = 46 * 4 + (L & 3); } else { const int L1 = L - 80; u.pn = L1 >> 2; u.pm = 47 * 4 + (L1 & 3); } u.g = 0; return true; }
    __device__ __forceinline__ const char* a_ptr(const Unit& u) const { return A + (size_t)u.pm * (tstep >> 2); }
    __device__ __forceinline__ const char* b_ptr(const Unit& u) const { return B + (size_t)u.pn * tstep; }
};
struct SchedR2 : SchedBase {
    const char* A; const char* B; int nM, G, c; size_t tstep, astride;
    __device__ __forceinline__ bool next(int i, Unit& u) const { const long L = (long)i * G + c; if (L >= (long)nM * 29) return false; tile_of((int)L, nM, 29, u.pm, u.pn); u.g = u.pn < 24 ? (u.pn >> 3) : (u.pn - 21); return true; }
    __device__ __forceinline__ const char* a_ptr(const Unit& u) const { return A + (size_t)u.g * astride + (size_t)u.pm * tstep; }
    __device__ __forceinline__ const char* b_ptr(const Unit& u) const { return B + (size_t)u.pn * tstep; }
};
struct SchedR3 : SchedBase {
    const char* A; const char* B; int nM, G, c; size_t tstep, astride;
    __device__ __forceinline__ bool next(int i, Unit& u) const { const long L = (long)i * G + c; if (L >= (long)nM * 40) return false; tile_of((int)L, nM, 40, u.pm, u.pn); u.g = u.pn >> 3; return true; }
    __device__ __forceinline__ const char* a_ptr(const Unit& u) const { return A + (size_t)u.g * astride + (size_t)u.pm * tstep; }
    __device__ __forceinline__ const char* b_ptr(const Unit& u) const { return B + (size_t)u.pn * tstep; }
};
struct SchedM3 : SchedBase {
    const char* A0; const char* B0; const char* A1; const char* B1; int nM0, nN0, nM1, nN1, G, c; size_t tstep;
    __device__ __forceinline__ bool next(int i, Unit& u) const { const long L = (long)i * G + c; const int n0 = nM0 * nN0; if (L >= (long)n0 + nM1 * nN1) return false;
        if (L < n0) { tile_of((int)L, nM0, nN0, u.pm, u.pn); u.g = 0; } else { tile_of((int)L - n0, nM1, nN1, u.pm, u.pn); u.g = 1; } return true; }
    __device__ __forceinline__ const char* a_ptr(const Unit& u) const { return (u.g ? A1 : A0) + (size_t)u.pm * tstep; }
    __device__ __forceinline__ const char* b_ptr(const Unit& u) const { return (u.g ? B1 : B0) + (size_t)u.pn * tstep; }
};

__device__ __forceinline__ unsigned cvt_pk_bf16(float lo, float hi) { unsigned r; asm volatile("s_nop 0\n\tv_cvt_pk_bf16_f32 %0, %1, %2" : "=v"(r) : "v"(lo), "v"(hi)); return r; }
typedef unsigned u32x2 __attribute__((ext_vector_type(2)));
__device__ __forceinline__ float fast_sigmoid(float x) { return __builtin_amdgcn_rcpf(1.0f + __builtin_amdgcn_exp2f(-1.44269504f * x)); }
__device__ __forceinline__ float fast_tanh(float x) { return 1.0f - 2.0f * __builtin_amdgcn_rcpf(1.0f + __builtin_amdgcn_exp2f(2.88539008f * x)); }

struct EpiF32 {
    static constexpr bool PERM = false, AFTER_DRAIN = false;
    float* C; int ldc;
    __device__ __forceinline__ void operator()(const f32x4 (&acc)[2][2][4][2], const Unit& u, int wr, int wc, int fr, int fq) const {
        const int row0 = u.pm * BM + wr * 64 + fr, col0 = u.pn * BM + wc * 32 + 4 * fq;
#pragma unroll
        for (int ai = 0; ai < 2; ++ai)
#pragma unroll
            for (int m = 0; m < 4; ++m) { float* rowp = C + (size_t)(row0 + ai * HALF + m * 16) * ldc + col0;
#pragma unroll
                for (int bj = 0; bj < 2; ++bj)
#pragma unroll
                    for (int n = 0; n < 2; ++n) *(f32x4*)(rowp + bj * HALF + n * 16) = acc[ai][bj][m][n]; }
    }
};
template <int MB> struct EpiSwigluT {
    static constexpr bool PERM = true, AFTER_DRAIN = false;
    bf16_t* U;
    __device__ __forceinline__ void operator()(const f32x4 (&acc)[2][2][MB][2], const Unit& u, int wr, int wc, int fr, int fq) const {
        const int row0 = u.pm * (64 * MB) + wr * (16 * MB) + fr, col0 = u.pn * HALF + wc * 32 + 8 * fq;
#pragma unroll
        for (int ai = 0; ai < 2; ++ai)
#pragma unroll
            for (int m = 0; m < MB; ++m) { bf16_t* rowp = U + (size_t)(row0 + ai * (32 * MB) + m * 16) * 5632 + col0;
                u32x4 w;
#pragma unroll
                for (int n = 0; n < 2; ++n) { const f32x4 g = acc[ai][0][m][n], v = acc[ai][1][m][n]; f32x4 o;
#pragma unroll
                    for (int e = 0; e < 4; ++e) o[e] = g[e] * fast_sigmoid(g[e]) * v[e];
                    w[2 * n] = cvt_pk_bf16(o[0], o[1]); w[2 * n + 1] = cvt_pk_bf16(o[2], o[3]); }
                *(u32x4*)rowp = w; }
    }
};
__device__ __forceinline__ float bf_lo(unsigned w) { return __builtin_bit_cast(float, w << 16); }
__device__ __forceinline__ float bf_hi(unsigned w) { return __builtin_bit_cast(float, w & 0xffff0000u); }
template <int MB> struct EpiResidT {
    static constexpr bool PERM = true, AFTER_DRAIN = false;
    bf16_t* X; const float* mod; float sc;
    __device__ __forceinline__ void operator()(const f32x4 (&acc)[2][2][MB][2], const Unit& u, int wr, int wc, int fr, int fq) const {
        if (sc == 0.f) return;
        const int col0 = u.pn * BM + wc * 32 + 8 * fq;
#pragma unroll
        for (int ai = 0; ai < 2; ++ai) {
            u32x4 xv[MB][2]; f32x4 g0[MB][2], g1[MB][2];
#pragma unroll
            for (int m = 0; m < MB; ++m) { const int rb = u.pm * (64 * MB) + ai * (32 * MB) + wr * (16 * MB) + m * 16;
                const int grp = rb < 8192 ? 0 : 1 + ((rb - 8192) >> 10);
                const float* gp = mod + (size_t)grp * (9 * 2048) + col0;
                const bf16_t* rowp = X + (size_t)(rb + fr) * 2048 + col0;
#pragma unroll
                for (int bj = 0; bj < 2; ++bj) { xv[m][bj] = *(const u32x4*)(rowp + bj * HALF); g0[m][bj] = *(const f32x4*)(gp + bj * HALF); g1[m][bj] = *(const f32x4*)(gp + bj * HALF + 4); } }
#pragma unroll
            for (int m = 0; m < MB; ++m) { const int rb = u.pm * (64 * MB) + ai * (32 * MB) + wr * (16 * MB) + m * 16;
                bf16_t* rowp = X + (size_t)(rb + fr) * 2048 + col0;
#pragma unroll
                for (int bj = 0; bj < 2; ++bj) { const u32x4 x = xv[m][bj]; const f32x4 ga = g0[m][bj] * sc, gb = g1[m][bj] * sc;
                    const f32x4 a0 = acc[ai][bj][m][0], a1 = acc[ai][bj][m][1];
                    u32x4 w;
                    w.x = cvt_pk_bf16(bf_lo(x.x) + ga[0] * a0[0], bf_hi(x.x) + ga[1] * a0[1]); w.y = cvt_pk_bf16(bf_lo(x.y) + ga[2] * a0[2], bf_hi(x.y) + ga[3] * a0[3]);
                    w.z = cvt_pk_bf16(bf_lo(x.z) + gb[0] * a1[0], bf_hi(x.z) + gb[1] * a1[1]); w.w = cvt_pk_bf16(bf_lo(x.w) + gb[2] * a1[2], bf_hi(x.w) + gb[3] * a1[3]);
                    *(u32x4*)(rowp + bj * HALF) = w; } }
        }
    }
};
struct EpiM3 {
    static constexpr bool PERM = true, AFTER_DRAIN = false;
    bf16_t* Q; bf16_t* KV;
    __device__ __forceinline__ void operator()(const f32x4 (&acc)[2][2][4][2], const Unit& u, int wr, int wc, int fr, int fq) const {
        const int row0 = u.pm * BM + wr * 64 + fr, col0 = u.pn * BM + wc * 32 + 8 * fq;
        bf16_t* base = u.g ? KV : Q; const int ldc = u.g ? 4096 : 3072;
#pragma unroll
        for (int ai = 0; ai < 2; ++ai)
#pragma unroll
            for (int m = 0; m < 4; ++m) { bf16_t* rowp = base + (size_t)(row0 + ai * HALF + m * 16) * ldc + col0;
#pragma unroll
                for (int bj = 0; bj < 2; ++bj) { const f32x4 o0 = acc[ai][bj][m][0], o1 = acc[ai][bj][m][1];
                    u32x4 w; w.x = cvt_pk_bf16(o0[0], o0[1]); w.y = cvt_pk_bf16(o0[2], o0[3]); w.z = cvt_pk_bf16(o1[0], o1[1]); w.w = cvt_pk_bf16(o1[2], o1[3]); *(u32x4*)(rowp + bj * HALF) = w; } }
    }
};
struct EpiR2 {
    static constexpr bool PERM = true, AFTER_DRAIN = false;
    bf16_t* RKV; size_t rkv_stride; bf16_t* T1; size_t t1_stride; size_t rows_total;
    __device__ __forceinline__ void operator()(const f32x4 (&acc)[2][2][4][2], const Unit& u, int wr, int wc, int fr, int fq) const {
        const int row0 = u.pm * BM + wr * 64 + fr;
        if (u.g < 3) {
            bf16_t* base = RKV + (size_t)u.g * rkv_stride;
            const int hq = (u.pn & 7) * 4 + (wc >> 1), cin = (wc & 1) * 32 + 8 * fq;
            const unsigned voff = (unsigned)(row0 * 64 + cin);
#pragma unroll
            for (int bj = 0; bj < 2; ++bj) { bf16_t* hb = base + (size_t)(hq + bj * 2) * rows_total * 64;
#pragma unroll
                for (int ai = 0; ai < 2; ++ai)
#pragma unroll
                    for (int m = 0; m < 4; ++m) { const f32x4 o0 = acc[ai][bj][m][0], o1 = acc[ai][bj][m][1];
                        u32x4 w; w.x = cvt_pk_bf16(o0[0], o0[1]); w.y = cvt_pk_bf16(o0[2], o0[3]); w.z = cvt_pk_bf16(o1[0], o1[1]); w.w = cvt_pk_bf16(o1[2], o1[3]);
                        *(u32x4*)(hb + (voff + (unsigned)((ai * HALF + m * 16) * 64))) = w; } }
        } else {
            const int slot = u.g - 3; bf16_t* base = T1 + (size_t)slot * t1_stride + wc * 32 + 8 * fq;
            const int act = slot == 0 ? 1 : ((slot & 1) ? 2 : 0);
#pragma unroll
            for (int ai = 0; ai < 2; ++ai)
#pragma unroll
                for (int m = 0; m < 4; ++m) { bf16_t* rowp = base + (size_t)(row0 + ai * HALF + m * 16) * 256;
#pragma unroll
                    for (int bj = 0; bj < 2; ++bj) { u32x4 w;
#pragma unroll
                        for (int n = 0; n < 2; ++n) { f32x4 o = acc[ai][bj][m][n];
                            if (act == 1) { _Pragma("unroll") for (int e = 0; e < 4; ++e) o[e] = fast_sigmoid(o[e]); }
                            else if (act == 2) { _Pragma("unroll") for (int e = 0; e < 4; ++e) o[e] = fast_tanh(o[e]); }
                            w[2 * n] = cvt_pk_bf16(o[0], o[1]); w[2 * n + 1] = cvt_pk_bf16(o[2], o[3]); }
                        *(u32x4*)(rowp + bj * HALF) = w; } }
        }
    }
};
__device__ __forceinline__ unsigned cvt_pk_unorm16(float lo, float hi) { unsigned r; asm volatile("s_nop 0\n\tv_cvt_pknorm_u16_f32 %0, %1, %2" : "=v"(r) : "v"(lo), "v"(hi)); return r; }
struct EpiR3 {
    static constexpr bool PERM = true, AFTER_DRAIN = false;
    bf16_t* G; bf16_t* DEC; bf16_t* AA; size_t dstride; const float* w0; const float* a0; size_t rows_total;
    template <int KIND> __device__ __forceinline__ void run(const f32x4 (&acc)[2][2][4][2], bf16_t* base, const float* bp, int row0, int hq, int cin) const {
#pragma unroll
        for (int bj = 0; bj < 2; ++bj) { f32x4 bv0 = (f32x4){0.f, 0.f, 0.f, 0.f}, bv1 = bv0; if (KIND != 0) { bv0 = *(const f32x4*)(bp + bj * HALF); bv1 = *(const f32x4*)(bp + bj * HALF + 4); }
            bf16_t* hb = KIND == 0 ? base : base + (size_t)(hq + bj * 2) * rows_total * 64;
            const unsigned voff = KIND == 0 ? (unsigned)(row0 * 2048 + cin + bj * HALF) : (unsigned)(row0 * 64 + cin);
#pragma unroll
            for (int ai = 0; ai < 2; ++ai)
#pragma unroll
                for (int m = 0; m < 4; ++m) { f32x4 o0 = acc[ai][bj][m][0] + bv0, o1 = acc[ai][bj][m][1] + bv1; const int rr_ = ai * HALF + m * 16; u32x4 w;
                    if (KIND == 1) { _Pragma("unroll") for (int e = 0; e < 4; ++e) { o0[e] = 2.0f * __builtin_amdgcn_exp2f((-0.60653066f * 1.44269504f) * fast_sigmoid(o0[e])) - 1.0f; o1[e] = 2.0f * __builtin_amdgcn_exp2f((-0.60653066f * 1.44269504f) * fast_sigmoid(o1[e])) - 1.0f; } }
                    if (KIND == 2) { _Pragma("unroll") for (int e = 0; e < 4; ++e) { o0[e] = fast_sigmoid(o0[e]); o1[e] = fast_sigmoid(o1[e]); } }
                    if (KIND == 0) { w.x = cvt_pk_bf16(o0[0], o0[1]); w.y = cvt_pk_bf16(o0[2], o0[3]); w.z = cvt_pk_bf16(o1[0], o1[1]); w.w = cvt_pk_bf16(o1[2], o1[3]); }
                    else { w.x = cvt_pk_unorm16(o0[0], o0[1]); w.y = cvt_pk_unorm16(o0[2], o0[3]); w.z = cvt_pk_unorm16(o1[0], o1[1]); w.w = cvt_pk_unorm16(o1[2], o1[3]); }
                    *(u32x4*)(hb + (voff + (unsigned)(rr_ * (KIND == 0 ? 2048 : 64)))) = w; } }
    }
    __device__ __forceinline__ void operator()(const f32x4 (&acc)[2][2][4][2], const Unit& u, int wr, int wc, int fr, int fq) const {
        const int lane_ = lane_id_v(), fq8 = 8 * (lane_ >> 4);
        const int row0 = u.pm * BM + wr * 64 + (lane_ & 15), col0 = (u.pn & 7) * BM + wc * 32 + fq8;
        const int hq = (u.pn & 7) * 4 + (wc >> 1), cin = (wc & 1) * 32 + fq8;
        const int slot = u.g, dir = slot == 0 ? 0 : ((slot - 1) >> 1);
        if (slot == 0) run<0>(acc, G, w0, row0, hq, col0);
        else if (slot & 1) run<1>(acc, DEC + (size_t)dir * dstride, w0 + dir * 2048 + col0, row0, hq, cin);
        else run<2>(acc, AA + (size_t)dir * dstride, a0 + dir * 2048 + col0, row0, hq, cin);
    }
};
}
#define LAS __attribute__((address_space(3)))
#define XB_TMO      128
#define XB_XCNT(j)  (256  + 64 * (j))
#define XB_XSUB(j)  (1280 + 64 * (j))
#define XB_XGEN(j)  (2304 + 64 * (j))
#define XB_TOP      3328
#define XB_TOPGEN   3392
#define XCD_BAR_WORDS 3456
#define XB_SPIN_CAP (1u << 18)


__device__ __forceinline__ unsigned xb_ld(unsigned* p)              { return __hip_atomic_load(p, __ATOMIC_RELAXED, __HIP_MEMORY_SCOPE_AGENT); }
__device__ __forceinline__ unsigned xb_add(unsigned* p, unsigned v) { return __hip_atomic_fetch_add(p, v, __ATOMIC_RELAXED, __HIP_MEMORY_SCOPE_AGENT); }
__device__ __forceinline__ unsigned xb_xcc_id() { return (unsigned)__builtin_amdgcn_s_getreg((3 << 11) | 20) & 0xFu; }
#define XB_SPIN(cond, bar) do { unsigned _sp = 0; while (cond) { __builtin_amdgcn_s_sleep(1); \
    if ((++_sp & 255u) == 0u) { if (xb_ld(&(bar)[XB_TMO])) break; if (_sp > XB_SPIN_CAP) { atomicAdd(&(bar)[XB_TMO], 1u); break; } } } } while (0)

struct XcdBarrier {
    unsigned* bar; unsigned x; unsigned lead;
    volatile LAS unsigned* st;
};

__device__ __forceinline__ XcdBarrier xcd_barrier_post(unsigned* bar, volatile LAS unsigned* st) {
    XcdBarrier b; b.bar = bar; b.x = xb_xcc_id(); b.st = st; b.lead = threadIdx.x == 0 ? 1u : 0u;
    if (threadIdx.x == 0) (void)xb_add(&bar[XB_XCNT(b.x)], 1u);
    return b;
}
__device__ __forceinline__ void xcd_barrier_complete(unsigned* bar, unsigned x, unsigned& nloc, unsigned& nx) {
    const unsigned G = gridDim.x * gridDim.y * gridDim.z;
    unsigned sum, cnt, mine, sp = 0u;
    for (;;) {
        sum = 0u; cnt = 0u; mine = 0u;
#pragma unroll
        for (unsigned j = 0; j < 16; ++j) { const unsigned c = xb_ld(&bar[XB_XCNT(j)]); sum += c; cnt += (c > 0u) ? 1u : 0u; mine = (j == x) ? c : mine; }
        if (sum == G) break;
        __builtin_amdgcn_s_sleep(1);
        if ((++sp & 255u) == 0u) { if (xb_ld(&bar[XB_TMO])) break; if (sp > XB_SPIN_CAP) { atomicAdd(&bar[XB_TMO], 1u); break; } }
    }
    nloc = mine > 0u ? mine : 1u; nx = cnt > 0u ? cnt : 1u;
}

__device__ __forceinline__ void xcd_barrier(const XcdBarrier& b) {
    asm volatile("s_waitcnt vmcnt(0)" ::: "memory");
    __syncthreads();
    if (b.lead) {
        unsigned* bar = b.bar;
        __builtin_amdgcn_s_waitcnt(0);
        unsigned nloc = b.st[0], nx = b.st[1];
        if (nloc == 0u) { xcd_barrier_complete(bar, b.x, nloc, nx); b.st[0] = nloc; b.st[1] = nx; }
        const unsigned old = xb_add(&bar[XB_XSUB(b.x)], 1u);
        const unsigned gen = old / nloc;
        if (old + 1u == (gen + 1u) * nloc) {
            __builtin_amdgcn_fence(__ATOMIC_RELEASE, "agent");
            asm volatile("s_waitcnt vmcnt(0)" ::: "memory");
            const unsigned og = xb_add(&bar[XB_TOP], 1u);
            const unsigned tg = og / nx;
            if (og + 1u == (tg + 1u) * nx) xb_add(&bar[XB_TOPGEN], 1u);
            else XB_SPIN(xb_ld(&bar[XB_TOPGEN]) == tg, bar);
            __builtin_amdgcn_fence(__ATOMIC_ACQUIRE, "agent");
            xb_add(&bar[XB_XGEN(b.x)], 1u);
            asm volatile("s_waitcnt vmcnt(0)" ::: "memory");
        } else {
            XB_SPIN(xb_ld(&bar[XB_XGEN(b.x)]) == gen, bar);
            __builtin_amdgcn_fence(__ATOMIC_ACQUIRE, "agent");
            asm volatile("s_waitcnt vmcnt(0)" ::: "memory");
        }
    }
    __syncthreads();
}


constexpr int D = 2048, MP = 8192, MS = 4096, M = 12288, DFF = 5632, NFI = 11264, KVROWS = 14336;
constexpr int NWAVES = 8, NTHR = 512;
constexpr float RMS_EPS = 1e-6f, GN_EPS = 64e-5f;
constexpr size_t MiB = 1u << 20;
constexpr size_t WS_CTL = 0, CTL_ZERO_BYTES = 1 * MiB;
constexpr size_t WS_MOD = 1 * MiB;
constexpr size_t WS_X = 4 * MiB;
constexpr size_t WS_H = 100 * MiB;
constexpr size_t WS_U = 148 * MiB;
constexpr size_t WS_WFI = 280 * MiB;
constexpr size_t WS_WFO = 632 * MiB;
constexpr size_t WS_WMLA = 808 * MiB;
constexpr size_t WS_WRW = 848 * MiB;
constexpr size_t WS_ACT = 932 * MiB;
constexpr size_t A_RAW = WS_ACT, A_CQ = WS_ACT + 60 * MiB, A_CKV = WS_ACT + 72 * MiB, A_KR = WS_ACT + 86 * MiB, A_Q = WS_ACT + 88 * MiB, A_KV = WS_ACT + 160 * MiB, A_O = WS_ACT + 272 * MiB;
constexpr size_t B_XMIX = WS_ACT, B_DEC = WS_ACT, B_AA = WS_ACT + 192 * MiB, B_RKV = WS_ACT + 384 * MiB, B_G = WS_ACT + 672 * MiB, B_T1 = WS_ACT + 768 * MiB, B_Y = WS_ACT + 798 * MiB,
                 B_BON = WS_ACT + 990 * MiB, B_O2 = WS_ACT + 993 * MiB;
constexpr size_t WS_END = WS_ACT + 1041 * MiB;
constexpr size_t O_YP = 0, O_YS = 16777216, O_CKV = 25165824, O_KR = 33554432, O_SF = 34603008, O_SB = 42991616, O_END = 51380224;
constexpr int CW_BAR = 4096, CW_DBG = 64;
constexpr int LDS_BYTES = 147456, MISC_OFF = LDS_BYTES - 256;

#define GAS __attribute__((address_space(1)))
typedef unsigned short bf16;
typedef unsigned v4u __attribute__((ext_vector_type(4)));
typedef unsigned v2u __attribute__((ext_vector_type(2)));
typedef float f32x4 __attribute__((ext_vector_type(4)));
typedef float f32x2 __attribute__((ext_vector_type(2)));
typedef short bf16x8 __attribute__((ext_vector_type(8)));
typedef short s16x4 __attribute__((ext_vector_type(4)));
#define LDS_WAIT() asm volatile("s_waitcnt lgkmcnt(0)" ::: "memory")
__device__ __forceinline__ unsigned f2bf(float f) { unsigned u = __builtin_bit_cast(unsigned, f); return (u + 0x7fffu + ((u >> 16) & 1u)) >> 16; }
__device__ __forceinline__ unsigned pk2(float lo, float hi) { return f2bf(lo) | (f2bf(hi) << 16); }
__device__ __forceinline__ float bflo(unsigned w) { return __builtin_bit_cast(float, w << 16); }
__device__ __forceinline__ float bfhi(unsigned w) { return __builtin_bit_cast(float, w & 0xffff0000u); }
__device__ __forceinline__ float xdpp(float v, int ctrl_b1_or_4e) { return ctrl_b1_or_4e == 1 ? __builtin_bit_cast(float, __builtin_amdgcn_update_dpp(0, __builtin_bit_cast(int, v), 0xB1, 0xF, 0xF, true))
                                                                                             : __builtin_bit_cast(float, __builtin_amdgcn_update_dpp(0, __builtin_bit_cast(int, v), 0x4E, 0xF, 0xF, true)); }
__device__ __forceinline__ float xswz4(float v) { return __builtin_bit_cast(float, __builtin_amdgcn_ds_swizzle(__builtin_bit_cast(int, v), 0x101F)); }
__device__ __forceinline__ float xswz8(float v) { return __builtin_bit_cast(float, __builtin_amdgcn_ds_swizzle(__builtin_bit_cast(int, v), 0x201F)); }
__device__ __forceinline__ float xswz16(float v) { return __builtin_bit_cast(float, __builtin_amdgcn_ds_swizzle(__builtin_bit_cast(int, v), 0x401F)); }
__device__ __forceinline__ float sum_x32(float v) { unsigned a_ = __builtin_bit_cast(unsigned, v), b_ = a_; asm volatile("" : "+v"(b_));
    auto r = __builtin_amdgcn_permlane32_swap(a_, b_, false, false); const unsigned r0 = r[0], r1 = r[1];
    return __builtin_bit_cast(float, r0) + __builtin_bit_cast(float, r1); }
__device__ __forceinline__ float max_x32(float v) { unsigned a_ = __builtin_bit_cast(unsigned, v), b_ = a_; asm volatile("" : "+v"(b_));
    auto r = __builtin_amdgcn_permlane32_swap(a_, b_, false, false); const unsigned r0 = r[0], r1 = r[1];
    return fmaxf(__builtin_bit_cast(float, r0), __builtin_bit_cast(float, r1)); }
__device__ __forceinline__ float quad_sum(float v) { v += xdpp(v, 1); v += xdpp(v, 2); return v; }
__device__ __forceinline__ float sum16(float v) { v = quad_sum(v);
    v += __builtin_bit_cast(float, __builtin_amdgcn_update_dpp(0, __builtin_bit_cast(int, v), 0x141, 0xF, 0xF, true));
    v += __builtin_bit_cast(float, __builtin_amdgcn_update_dpp(0, __builtin_bit_cast(int, v), 0x140, 0xF, 0xF, true));
    return v; }
__device__ __forceinline__ float wave_sum(float v) { v = sum16(v); v += xswz16(v); return sum_x32(v); }

struct Params { const float* in[40]; float* out; unsigned char* ws; int ph_lo, ph_hi; };
#define CAS __attribute__((address_space(4)))
struct InProxy { const CAS Params* p; __device__ __forceinline__ const float* operator[](int i) const { return p->in[i]; } };
struct PP { InProxy in; float* out; unsigned char* ws; };
__device__ __forceinline__ PP make_pp() {
    const unsigned long long a = (unsigned long long)(const CAS void*)__builtin_amdgcn_kernarg_segment_ptr(); const unsigned lo_ = (unsigned)pg8::opaque_s((int)(unsigned)a), hi_ = (unsigned)pg8::opaque_s((int)(unsigned)(a >> 32));
    const CAS Params* p = (const CAS Params*)(((unsigned long long)hi_ << 32) | lo_); PP r; r.in.p = p; r.out = p->out; r.ws = p->ws; return r; }
using pg8::opaque_v; using pg8::opaque_s;
struct Ctx {
    LAS unsigned char* lds; int tid, lane, wave, G, vcu, gw, ngw;
};

struct TJob { const float* W; bf16* WT; int K, N, ldw, Kpad, Npad, ldk, mode, row_off; };
__device__ __forceinline__ void transpose_item(const TJob& J, int item, LAS float* scr, int lane) {
    const int nblk = J.Npad >> 6, kb = item / nblk, nb = item - kb * nblk, k0 = kb << 6, n0 = nb << 6;
    const int kq = lane >> 4, nq = lane & 15, n = n0 + 4 * nq; const bool nok = n < J.N;
    f32x4 v[16];
#pragma unroll
    for (int i = 0; i < 16; ++i) { const int k = k0 + 4 * i + kq; v[i] = (f32x4){0.f, 0.f, 0.f, 0.f}; if (nok && k < J.K) v[i] = __builtin_nontemporal_load((const f32x4*)(J.W + (size_t)k * J.ldw + n)); }
#pragma unroll
    for (int i = 0; i < 16; ++i) { LAS float* s = scr + (4 * i + kq) * 65 + 4 * nq; s[0] = v[i][0]; s[1] = v[i][1]; s[2] = v[i][2]; s[3] = v[i][3];
        if ((i & 3) == 3) asm volatile("s_waitcnt lgkmcnt(4)" ::: "memory"); }
    LDS_WAIT(); asm volatile("" ::: "memory");
    int rbase;
    if (J.mode == 1) rbase = n0 < DFF ? (n0 >> 7) * 256 + (n0 & 127) : ((n0 - DFF) >> 7) * 256 + 128 + ((n0 - DFF) & 127);
    else rbase = J.row_off + n0;
    const int nn = lane >> 3, c = lane & 7;
    float t[2][8];
#pragma unroll
    for (int e = 0; e < 8; ++e) t[0][e] = (scr + (8 * c) * 65 + nn)[e * 65];
#pragma unroll
    for (int j = 0; j < 8; ++j) { const int nl = nn + 8 * j;
        if (j + 1 < 8) { const LAS float* s = scr + (8 * c) * 65 + nl + 8;
#pragma unroll
            for (int e = 0; e < 8; ++e) t[(j + 1) & 1][e] = s[e * 65];
            asm volatile("s_waitcnt lgkmcnt(8)" ::: "memory"); }
        else asm volatile("s_waitcnt lgkmcnt(0)" ::: "memory");
        v4u o; o.x = pk2(t[j & 1][0], t[j & 1][1]); o.y = pk2(t[j & 1][2], t[j & 1][3]); o.z = pk2(t[j & 1][4], t[j & 1][5]); o.w = pk2(t[j & 1][6], t[j & 1][7]);
        __builtin_nontemporal_store(o, (v4u*)(J.WT + (size_t)(rbase + nl) * J.ldk + k0 + 8 * c)); }
    LDS_WAIT(); asm volatile("" ::: "memory");
}
constexpr int IT_FI = 32 * 176, IT_FO = 88 * 32, IT_MLA = 2560, IT_RW = 5376;
constexpr int IT_TOTAL = 8 * IT_FI + 8 * IT_FO + 2 * IT_MLA + 2 * IT_RW;
__device__ __forceinline__ void make_job(const PP& P, int it, TJob& J, int& item) {
    unsigned char* ws = P.ws;
    J.mode = 0; J.row_off = 0;
    if (it < 8 * IT_FI) { const int mi = it / IT_FI; item = it - mi * IT_FI; J.W = P.in[12] + (size_t)mi * D * NFI; J.WT = (bf16*)(ws + WS_WFI) + (size_t)mi * NFI * D; J.K = D; J.N = NFI; J.ldw = NFI; J.Kpad = D; J.Npad = NFI; J.ldk = D; J.mode = 1; return; }
    it -= 8 * IT_FI;
    if (it < 8 * IT_FO) { const int mi = it / IT_FO; item = it - mi * IT_FO; J.W = P.in[13] + (size_t)mi * DFF * D; J.WT = (bf16*)(ws + WS_WFO) + (size_t)mi * D * DFF; J.K = DFF; J.N = D; J.ldw = D; J.Kpad = DFF; J.Npad = D; J.ldk = DFF; return; }
    it -= 8 * IT_FO;
    if (it < 2 * IT_MLA) { const int j = it / IT_MLA; it -= j * IT_MLA; unsigned char* wb = ws + WS_WMLA + (size_t)j * 20 * MiB;
        if (it < 256) { item = it; J.W = P.in[14] + (size_t)j * D * 512; J.WT = (bf16*)wb; J.K = D; J.N = 512; J.ldw = 512; J.Kpad = D; J.Npad = 512; J.ldk = D; return; }
        it -= 256;
        if (it < 288) { item = it; J.W = P.in[17] + (size_t)j * D * 576; J.WT = (bf16*)wb; J.K = D; J.N = 576; J.ldw = 576; J.Kpad = D; J.Npad = 576; J.ldk = D; J.row_off = 512; return; }
        it -= 288;
        if (it < 96) { item = it; J.W = P.in[17]; J.WT = (bf16*)wb; J.K = D; J.N = 0; J.ldw = 576; J.Kpad = D; J.Npad = 192; J.ldk = D; J.row_off = 1088; return; }
        it -= 96;
        if (it < 384) { item = it; J.W = P.in[16] + (size_t)j * 512 * 3072; J.WT = (bf16*)(wb + 5 * MiB); J.K = 512; J.N = 3072; J.ldw = 3072; J.Kpad = 512; J.Npad = 3072; J.ldk = 512; return; }
        it -= 384;
        if (it < 512) { item = it; J.W = P.in[19] + (size_t)j * 512 * 4096; J.WT = (bf16*)(wb + 8 * MiB); J.K = 512; J.N = 4096; J.ldw = 4096; J.Kpad = 512; J.Npad = 4096; J.ldk = 512; return; }
        it -= 512;
        item = it; J.W = P.in[20] + (size_t)j * D * D; J.WT = (bf16*)(wb + 12 * MiB); J.K = D; J.N = D; J.ldw = D; J.Kpad = D; J.Npad = D; J.ldk = D; return; }
    it -= 2 * IT_MLA;
    { const int j = it / IT_RW; it -= j * IT_RW; unsigned char* wb = ws + WS_WRW + (size_t)j * 42 * MiB;
        if (it < 3072) { const int mi = it >> 10; item = it & 1023; J.W = P.in[23 + mi] + (size_t)j * D * D; J.WT = (bf16*)wb; J.K = D; J.N = D; J.ldw = D; J.Kpad = D; J.Npad = D; J.ldk = D; J.row_off = mi * D; return; }
        it -= 3072;
        if (it < 640) { const int slot = it >> 7; item = it & 127; J.WT = (bf16*)wb; J.K = D; J.Kpad = D; J.Npad = 256; J.ldk = D; J.row_off = 6144 + slot * 256;
            if (slot == 0) { J.W = P.in[32] + (size_t)j * D * 256; J.N = 256; J.ldw = 256; }
            else { const int dir = (slot - 1) >> 1, isa = (slot - 1) & 1; J.W = P.in[isa ? 30 : 27] + (size_t)(j * 2 + dir) * D * 96; J.N = 96; J.ldw = 96; }
            return; }
        it -= 640;
        if (it < 640) { const int slot = it >> 7; item = it & 127; J.WT = (bf16*)(wb + 29 * MiB); J.Kpad = 256; J.N = D; J.ldw = D; J.Npad = D; J.ldk = 256; J.row_off = slot * D;
            if (slot == 0) { J.W = P.in[33] + (size_t)j * 256 * D; J.K = 256; }
            else { const int dir = (slot - 1) >> 1, isa = (slot - 1) & 1; J.W = P.in[isa ? 31 : 28] + (size_t)(j * 2 + dir) * 96 * D; J.K = 96; }
            return; }
        it -= 640;
        item = it; J.W = P.in[39] + (size_t)j * D * D; J.WT = (bf16*)(wb + 34 * MiB); J.K = D; J.N = D; J.ldw = D; J.Kpad = D; J.Npad = D; J.ldk = D; return; }
}
__device__ __forceinline__ void ada_strip(const PP& P, int s, int lane) {
    const int l = s / 288, col = (s - l * 288) * 64 + lane;
    const float* W = P.in[8] + (size_t)l * D * 18432 + col;
    float acc[5] = {0.f, 0.f, 0.f, 0.f, 0.f};
    for (int kc = 0; kc < D; kc += 64) {
        float sv[5];
#pragma unroll
        for (int g = 0; g < 5; ++g) { const float x = g == 0 ? P.in[7][kc + lane] : P.in[6][(g - 1) * D + kc + lane]; sv[g] = x / (1.0f + __expf(-x)); }
#pragma unroll 16
        for (int j = 0; j < 64; ++j) { const float w = __builtin_nontemporal_load(W + (size_t)(kc + j) * 18432);
#pragma unroll
            for (int g = 0; g < 5; ++g) acc[g] += __builtin_bit_cast(float, __builtin_amdgcn_readlane(__builtin_bit_cast(int, sv[g]), j)) * w; }
    }
    float* mod = (float*)(P.ws + WS_MOD);
    const float b = P.in[9][(size_t)l * 18432 + col];
#pragma unroll
    for (int g = 0; g < 5; ++g) mod[(size_t)(l * 5 + g) * 18432 + col] = acc[g] + b;
}
constexpr int IT_EARLY = 4 * IT_FI + 4 * IT_FO + IT_MLA + IT_RW, IT_LATE_A = 3 * IT_FI + 3 * IT_FO + IT_MLA + IT_RW, IT_LATE_B = IT_FI + IT_FO;
static_assert(IT_EARLY + IT_LATE_A + IT_LATE_B == IT_TOTAL, "item split");
__device__ __forceinline__ int early_item(int e) {
    if (e < 4 * IT_FI) { const int q = e / IT_FI, r = e - q * IT_FI; return (q < 3 ? q : 6) * IT_FI + r; } e -= 4 * IT_FI;
    if (e < 4 * IT_FO) { const int q = e / IT_FO, r = e - q * IT_FO; return 8 * IT_FI + (q < 3 ? q : 6) * IT_FO + r; } e -= 4 * IT_FO;
    if (e < IT_MLA) return 8 * IT_FI + 8 * IT_FO + e; e -= IT_MLA;
    return 8 * IT_FI + 8 * IT_FO + 2 * IT_MLA + e;
}
__device__ __forceinline__ int late_item(int t, int set) {
    if (set == 0) {
        if (t < 3 * IT_FI) return 3 * IT_FI + t; t -= 3 * IT_FI;
        if (t < 3 * IT_FO) return 8 * IT_FI + 3 * IT_FO + t; t -= 3 * IT_FO;
        if (t < IT_MLA) return 8 * IT_FI + 8 * IT_FO + IT_MLA + t; t -= IT_MLA;
        return 8 * IT_FI + 8 * IT_FO + 2 * IT_MLA + IT_RW + t;
    }
    if (t < IT_FI) return 7 * IT_FI + t; t -= IT_FI;
    return 8 * IT_FI + 7 * IT_FO + t;
}
__device__ __forceinline__ void p0_prologue(const PP& P, const Ctx& C) {
    LAS float* scr = (LAS float*)(C.lds + C.wave * 16640);
    for (int s = C.gw; s < 1152; s += C.ngw) ada_strip(P, s, C.lane);
    for (int e = (C.ngw - 1 - C.gw); e < IT_EARLY; e += C.ngw) { TJob J; int item; make_job(P, early_item(e), J, item); transpose_item(J, item, scr, C.lane); }
    v4u* X8 = (v4u*)(P.ws + WS_X); const f32x4* xp = (const f32x4*)P.in[0]; const f32x4* xs = (const f32x4*)P.in[1];
    const int nthr = C.G * NTHR; constexpr int NP8 = MP * D / 8, NA8 = M * D / 8;
    for (int i = C.vcu * NTHR + C.tid; i < NA8; i += nthr) { const f32x4* s = i < NP8 ? xp + 2 * (size_t)i : xs + 2 * (size_t)(i - NP8); const f32x4 a = s[0], b = s[1];
        v4u w; w.x = pk2(a[0], a[1]); w.y = pk2(a[2], a[3]); w.z = pk2(b[0], b[1]); w.w = pk2(b[2], b[3]); X8[i] = w; }
}

__device__ __forceinline__ int grp_of_row(int r) { return r < MP ? 0 : 1 + ((r - MP) >> 10); }
__device__ __forceinline__ void phase_norm(const PP& P, const Ctx& C, int l, int s) {
    const bf16* X = (const bf16*)(P.ws + WS_X); bf16* H = (bf16*)(P.ws + WS_H);
    const float* g = P.in[10] + (size_t)(l * 3 + s) * D; const float* mod = (const float*)(P.ws + WS_MOD) + (size_t)l * 5 * 18432;
    int cur = -1; f32x4 ca[8], cb[8];
    for (int r = C.gw; r < M; r += C.ngw) {
        const int grp = grp_of_row(r);
        if (grp != cur) { cur = grp; const float* sh = mod + (size_t)grp * 18432 + (3 * s) * D; const float* sc = sh + D;
#pragma unroll
            for (int j = 0; j < 8; ++j) { const int c = 8 * C.lane + 512 * (j >> 1) + 4 * (j & 1); const f32x4 gg = *(const f32x4*)(g + c), ss = *(const f32x4*)(sc + c); ca[j] = gg * (ss + 1.0f); cb[j] = *(const f32x4*)(sh + c); } }
        f32x4 v[8]; float q = 0.f;
        if (l == 0 && s == 0) {
            const float* xsrc = r < MP ? P.in[0] + (size_t)r * D : P.in[1] + (size_t)(r - MP) * D;
#pragma unroll
            for (int j = 0; j < 8; ++j) v[j] = *(const f32x4*)(xsrc + 8 * C.lane + 512 * (j >> 1) + 4 * (j & 1));
        } else {
#pragma unroll
            for (int jj = 0; jj < 4; ++jj) { const v4u w = *(const v4u*)(X + (size_t)r * D + 8 * C.lane + 512 * jj);
                v[2 * jj] = (f32x4){bflo(w.x), bfhi(w.x), bflo(w.y), bfhi(w.y)}; v[2 * jj + 1] = (f32x4){bflo(w.z), bfhi(w.z), bflo(w.w), bfhi(w.w)}; }
        }
#pragma unroll
        for (int j = 0; j < 8; ++j) q += (v[j][0] * v[j][0] + v[j][1] * v[j][1]) + (v[j][2] * v[j][2] + v[j][3] * v[j][3]);
        const float rstd = 1.0f / sqrtf(wave_sum(q) * (1.0f / D) + RMS_EPS);
#pragma unroll
        for (int jj = 0; jj < 4; ++jj) { const f32x4 y0 = v[2 * jj] * rstd * ca[2 * jj] + cb[2 * jj], y1 = v[2 * jj + 1] * rstd * ca[2 * jj + 1] + cb[2 * jj + 1];
            v4u w; w.x = pk2(y0[0], y0[1]); w.y = pk2(y0[2], y0[3]); w.z = pk2(y1[0], y1[1]); w.w = pk2(y1[2], y1[3]); *(v4u*)(H + (size_t)r * D + 8 * C.lane + 512 * jj) = w; }
    }
}
__device__ __forceinline__ void phase_final(const PP& P, const Ctx& C) {
    const bf16* X = (const bf16*)(P.ws + WS_X); const float* g = P.in[11];
    f32x4 ca[8];
#pragma unroll
    for (int j = 0; j < 8; ++j) ca[j] = *(const f32x4*)(g + 8 * C.lane + 512 * (j >> 1) + 4 * (j & 1));
    for (int r = C.gw; r < M; r += C.ngw) {
        f32x4 v[8]; float q = 0.f;
#pragma unroll
        for (int jj = 0; jj < 4; ++jj) { const v4u w = *(const v4u*)(X + (size_t)r * D + 8 * C.lane + 512 * jj);
            v[2 * jj] = (f32x4){bflo(w.x), bfhi(w.x), bflo(w.y), bfhi(w.y)}; v[2 * jj + 1] = (f32x4){bflo(w.z), bfhi(w.z), bflo(w.w), bfhi(w.w)}; }
#pragma unroll
        for (int j = 0; j < 8; ++j) q += (v[j][0] * v[j][0] + v[j][1] * v[j][1]) + (v[j][2] * v[j][2] + v[j][3] * v[j][3]);
        const float rstd = 1.0f / sqrtf(wave_sum(q) * (1.0f / D) + RMS_EPS);
        float* o = P.out + O_YP + (size_t)r * D + 8 * C.lane;
#pragma unroll
        for (int j = 0; j < 8; ++j) *(f32x4*)(o + 512 * (j >> 1) + 4 * (j & 1)) = v[j] * rstd * ca[j];
    }
}

__device__ __forceinline__ float rope_inv(int f) { return __expf(-(float)f * (9.210340372f / 16.0f)); }
__device__ __forceinline__ float rope_lane(float x, int lane, int t) {
    const float xp = xswz16(x);
    const int axis = lane >> 5, half = (lane >> 4) & 1, f = lane & 15;
    const float pos = (float)(axis == 0 ? (t >> 6) : (t & 63)); const float ang = pos * rope_inv(f);
    float sn, cs; sincosf(ang, &sn, &cs);
    return half == 0 ? x * cs - xp * sn : x * cs + xp * sn;
}
__device__ __forceinline__ void phase_mla_norm(const PP& P, const Ctx& C, int j) {
    const float* RAW = (const float*)(P.ws + A_RAW); bf16* CQ = (bf16*)(P.ws + A_CQ); bf16* CKV = (bf16*)(P.ws + A_CKV); bf16* KR = (bf16*)(P.ws + A_KR);
    const float* qn = P.in[15] + j * 512; const float* kn = P.in[18] + j * 512;
    f32x4 gq[2], gk[2];
#pragma unroll
    for (int jj = 0; jj < 2; ++jj) { gq[jj] = *(const f32x4*)(qn + 4 * C.lane + 256 * jj); gk[jj] = *(const f32x4*)(kn + 4 * C.lane + 256 * jj); }
    for (int r = C.gw; r < M + 2048; r += C.ngw) {
        if (r < M) {
            const float* rw = RAW + (size_t)r * 1280;
            f32x4 a[2], b[2]; float qa = 0.f, qb = 0.f;
#pragma unroll
            for (int jj = 0; jj < 2; ++jj) { a[jj] = *(const f32x4*)(rw + 4 * C.lane + 256 * jj); b[jj] = *(const f32x4*)(rw + 512 + 4 * C.lane + 256 * jj);
                qa += (a[jj][0] * a[jj][0] + a[jj][1] * a[jj][1]) + (a[jj][2] * a[jj][2] + a[jj][3] * a[jj][3]); qb += (b[jj][0] * b[jj][0] + b[jj][1] * b[jj][1]) + (b[jj][2] * b[jj][2] + b[jj][3] * b[jj][3]); }
            const float kr = rw[1024 + C.lane];
            const float ra = 1.0f / sqrtf(wave_sum(qa) * (1.0f / 512) + RMS_EPS), rb = 1.0f / sqrtf(wave_sum(qb) * (1.0f / 512) + RMS_EPS);
            int kvrow; float krv = kr;
            if (r < MP) { kvrow = r; const int b_ = r >> 8, t = r & 255;
                float* oc = P.out + O_CKV + ((size_t)(b_ * 2 + j) * 256 + t) * 512;
#pragma unroll
                for (int jj = 0; jj < 2; ++jj) *(f32x4*)(oc + 4 * C.lane + 256 * jj) = b[jj] * rb * gk[jj];
                P.out[O_KR + ((size_t)(b_ * 2 + j) * 256 + t) * 64 + C.lane] = kr;
            } else { const int lb = (r - MP) >> 10, t = (r - MP) & 1023; kvrow = MP + lb * 1536 + 512 + t; krv = rope_lane(kr, C.lane, t); }
#pragma unroll
            for (int jj = 0; jj < 2; ++jj) { const f32x4 y = a[jj] * ra * gq[jj]; v2u w; w.x = pk2(y[0], y[1]); w.y = pk2(y[2], y[3]); *(v2u*)(CQ + (size_t)r * 512 + 4 * C.lane + 256 * jj) = w;
                const f32x4 z = b[jj] * rb * gk[jj]; v2u w2; w2.x = pk2(z[0], z[1]); w2.y = pk2(z[2], z[3]); *(v2u*)(CKV + (size_t)kvrow * 512 + 4 * C.lane + 256 * jj) = w2; }
            KR[(size_t)kvrow * 64 + C.lane] = (bf16)f2bf(krv);
        } else {
            const int q = r - M, lb = q >> 9, s = q & 511, kvrow = MP + lb * 1536 + s;
            const float* cc = P.in[2] + ((size_t)(lb * 2 + j) * 512 + s) * 512;
#pragma unroll
            for (int jj = 0; jj < 2; ++jj) { const f32x4 z = *(const f32x4*)(cc + 4 * C.lane + 256 * jj); v2u w2; w2.x = pk2(z[0], z[1]); w2.y = pk2(z[2], z[3]); *(v2u*)(CKV + (size_t)kvrow * 512 + 4 * C.lane + 256 * jj) = w2; }
            KR[(size_t)kvrow * 64 + C.lane] = (bf16)f2bf(P.in[3][((size_t)(lb * 2 + j) * 512 + s) * 64 + C.lane]);
        }
    }
}
__device__ __forceinline__ void phase_q_rope(const PP& P, const Ctx& C) {
    bf16* Q = (bf16*)(P.ws + A_Q);
    for (int it = C.gw; it < MS * 16; it += C.ngw) { const int rr = it >> 4, h = it & 15, t = rr & 1023;
        bf16* p = Q + (size_t)(MP + rr) * 3072 + h * 192 + 128 + C.lane;
        const float x = __builtin_bit_cast(float, (unsigned)(*p) << 16);
        *p = (bf16)f2bf(rope_lane(x, C.lane, t)); }
}

constexpr int AT_KSTR = 400, AT_VSTR = 288, AT_KBUF = 64 * AT_KSTR, AT_VBUF = 64 * AT_VSTR, AT_BUF = AT_KBUF + AT_VBUF;
__device__ __forceinline__ void attn_unit(const Ctx& C, const bf16* Q, const bf16* KV, const bf16* KR, bf16* O, int qrow0, int krow0, int T, int h, bool rope) {
    const int tid = C.tid, lane = C.lane, wave = C.wave, fr = lane & 15, fq = lane >> 4;
    LAS unsigned char* lds = C.lds;
    bf16x8 qf[2][6];
#pragma unroll
    for (int qb = 0; qb < 2; ++qb)
#pragma unroll
        for (int ks = 0; ks < 6; ++ks) qf[qb][ks] = *(const bf16x8*)(Q + (size_t)(qrow0 + wave * 32 + qb * 16 + fr) * 3072 + h * 192 + ks * 32 + fq * 8);
    if (rope) {
        const int half = fq >> 1, f0 = (fq & 1) * 8, paddr = (lane ^ 32) << 2;
#pragma unroll
        for (int qb = 0; qb < 2; ++qb) { const int t = (qrow0 + wave * 32 + qb * 16 + fr - MP) & 1023;
#pragma unroll
            for (int ax = 0; ax < 2; ++ax) { const float pos = (float)(ax == 0 ? (t >> 6) : (t & 63));
                const v4u own = __builtin_bit_cast(v4u, qf[qb][4 + ax]); v4u par, outw;
#pragma unroll
                for (int d = 0; d < 4; ++d) par[d] = (unsigned)__builtin_amdgcn_ds_bpermute(paddr, (int)own[d]);
#pragma unroll
                for (int d = 0; d < 4; ++d) { float o2[2];
#pragma unroll
                    for (int e = 0; e < 2; ++e) { const int f = f0 + 2 * d + e; const float rev = pos * rope_inv(f) * 0.15915494309189535f; const float sn = __builtin_amdgcn_sinf(rev), cs = __builtin_amdgcn_cosf(rev);
                        const float x = e ? bfhi(own[d]) : bflo(own[d]), xp = e ? bfhi(par[d]) : bflo(par[d]);
                        o2[e] = half == 0 ? x * cs - xp * sn : x * cs + xp * sn; }
                    outw[d] = pk2(o2[0], o2[1]); }
                qf[qb][4 + ax] = __builtin_bit_cast(bf16x8, outw); } }
    }
    f32x4 ot[2][8];
#pragma unroll
    for (int qb = 0; qb < 2; ++qb)
#pragma unroll
        for (int db = 0; db < 8; ++db) ot[qb][db] = (f32x4){0.f, 0.f, 0.f, 0.f};
    float mrun[2] = {-1e30f, -1e30f}, lrun[2] = {0.f, 0.f};
    const int nt = T >> 6;
    v4u st[5];
    const int key01 = tid >> 4, ch01 = tid & 15, key4 = tid >> 3, ch4 = tid & 7;
#define AT_LOAD(t) do { const size_t kr0 = (size_t)krow0 + (size_t)(t) * 64; \
        st[0] = *(const v4u*)(KV + (kr0 + key01) * 4096 + h * 256 + ch01 * 8); st[1] = *(const v4u*)(KV + (kr0 + 32 + key01) * 4096 + h * 256 + ch01 * 8); \
        st[2] = *(const v4u*)(KV + (kr0 + key01) * 4096 + h * 256 + 128 + ch01 * 8); st[3] = *(const v4u*)(KV + (kr0 + 32 + key01) * 4096 + h * 256 + 128 + ch01 * 8); \
        st[4] = *(const v4u*)(KR + (kr0 + key4) * 64 + ch4 * 8); } while (0)
#define AT_WRITE(b) do { LAS unsigned char* kb_ = lds + (b) * AT_BUF; LAS unsigned char* vb_ = kb_ + AT_KBUF; \
        *(LAS v4u*)(kb_ + key01 * AT_KSTR + ch01 * 16) = st[0]; *(LAS v4u*)(kb_ + (32 + key01) * AT_KSTR + ch01 * 16) = st[1]; \
        *(LAS v4u*)(vb_ + key01 * AT_VSTR + ch01 * 16) = st[2]; *(LAS v4u*)(vb_ + (32 + key01) * AT_VSTR + ch01 * 16) = st[3]; \
        *(LAS v4u*)(kb_ + key4 * AT_KSTR + 256 + ch4 * 16) = st[4]; } while (0)
    AT_LOAD(0); AT_WRITE(0);
    __syncthreads();
    const float sc2 = 0.07216878364870322f * 1.44269504088896f;
    for (int t = 0; t < nt; ++t) {
        if (t + 1 < nt) AT_LOAD(t + 1);
        LAS unsigned char* kb = lds + (t & 1) * AT_BUF; LAS unsigned char* vb = kb + AT_KBUF;
        f32x4 sacc[2][4];
#pragma unroll
        for (int qb = 0; qb < 2; ++qb)
#pragma unroll
            for (int kk = 0; kk < 4; ++kk) sacc[qb][kk] = (f32x4){0.f, 0.f, 0.f, 0.f};
#pragma unroll
        for (int ks = 0; ks < 6; ++ks)
#pragma unroll
            for (int kk = 0; kk < 4; ++kk) { const bf16x8 kf = *(const LAS bf16x8*)(kb + (kk * 16 + fr) * AT_KSTR + ks * 64 + fq * 16);
#pragma unroll
                for (int qb = 0; qb < 2; ++qb) sacc[qb][kk] = __builtin_amdgcn_mfma_f32_16x16x32_bf16(kf, qf[qb][ks], sacc[qb][kk], 0, 0, 0); }
        bf16x8 pf[2][2];
#pragma unroll
        for (int qb = 0; qb < 2; ++qb) {
            float mx = -1e30f;
#pragma unroll
            for (int kk = 0; kk < 4; ++kk)
#pragma unroll
                for (int e = 0; e < 4; ++e) { sacc[qb][kk][e] *= sc2; mx = fmaxf(mx, sacc[qb][kk][e]); }
            mx = fmaxf(mx, xswz16(mx)); mx = max_x32(mx);
            const float mnew = fmaxf(mrun[qb], mx), alpha = __builtin_amdgcn_exp2f(mrun[qb] - mnew);
            mrun[qb] = mnew;
            float ps = 0.f;
#pragma unroll
            for (int kk = 0; kk < 4; ++kk)
#pragma unroll
                for (int e = 0; e < 4; ++e) { const float p = __builtin_amdgcn_exp2f(sacc[qb][kk][e] - mnew); sacc[qb][kk][e] = p; ps += p; }
            lrun[qb] = lrun[qb] * alpha + ps;
#pragma unroll
            for (int db = 0; db < 8; ++db) ot[qb][db] = ot[qb][db] * alpha;
#pragma unroll
            for (int k2 = 0; k2 < 2; ++k2) { v4u w; w.x = pk2(sacc[qb][2 * k2][0], sacc[qb][2 * k2][1]); w.y = pk2(sacc[qb][2 * k2][2], sacc[qb][2 * k2][3]);
                w.z = pk2(sacc[qb][2 * k2 + 1][0], sacc[qb][2 * k2 + 1][1]); w.w = pk2(sacc[qb][2 * k2 + 1][2], sacc[qb][2 * k2 + 1][3]); pf[qb][k2] = __builtin_bit_cast(bf16x8, w); }
        }
#pragma unroll
        for (int db = 0; db < 8; ++db)
#pragma unroll
            for (int k2 = 0; k2 < 2; ++k2) {
                const s16x4 lo = __builtin_amdgcn_ds_read_tr16_b64_v4i16((LAS s16x4*)(vb + (k2 * 32 + fq * 4 + (fr >> 2)) * AT_VSTR + db * 32 + 8 * (fr & 3)));
                const s16x4 hi = __builtin_amdgcn_ds_read_tr16_b64_v4i16((LAS s16x4*)(vb + (k2 * 32 + 16 + fq * 4 + (fr >> 2)) * AT_VSTR + db * 32 + 8 * (fr & 3)));
                const bf16x8 vf = __builtin_shufflevector(lo, hi, 0, 1, 2, 3, 4, 5, 6, 7);
#pragma unroll
                for (int qb = 0; qb < 2; ++qb) ot[qb][db] = __builtin_amdgcn_mfma_f32_16x16x32_bf16(vf, pf[qb][k2], ot[qb][db], 0, 0, 0);
            }
        if (t + 1 < nt) AT_WRITE((t + 1) & 1);
        __syncthreads();
    }
#undef AT_LOAD
#undef AT_WRITE
#pragma unroll
    for (int qb = 0; qb < 2; ++qb) {
        float l = lrun[qb]; l += xswz16(l); l = sum_x32(l);
        const float inv = 1.0f / l;
        bf16* op = O + (size_t)(qrow0 + wave * 32 + qb * 16 + fr) * 2048 + h * 128 + fq * 4;
#pragma unroll
        for (int db = 0; db < 8; ++db) { const f32x4 o = ot[qb][db] * inv; v2u w; w.x = pk2(o[0], o[1]); w.y = pk2(o[2], o[3]); *(v2u*)(op + db * 16) = w; }
    }
}
__device__ __forceinline__ void phase_attn(const PP& P, const Ctx& C) {
    const bf16* Q = (const bf16*)(P.ws + A_Q); const bf16* KV = (const bf16*)(P.ws + A_KV); const bf16* KR = (const bf16*)(P.ws + A_KR); bf16* O = (bf16*)(P.ws + A_O);
    for (int vc = C.vcu; vc < 256; vc += C.G) {
#pragma unroll 1
        for (int k = 0; k < 3; ++k) {
            int qrow0, krow0, T, h;
            if (k == 0) { const int lb = vc >> 6, qblk = vc & 3; h = (vc >> 2) & 15; qrow0 = MP + lb * 1024 + qblk * 256; krow0 = MP + lb * 1536; T = 1536; }
            else { const int u = vc + 256 * (k - 1), b = u >> 4; h = u & 15; qrow0 = b * 256; krow0 = b * 256; T = 256; }
            attn_unit(C, Q, KV, KR, O, qrow0, krow0, T, h, k == 0);
        }
    }
}

__device__ __forceinline__ void phase_shift(const PP& P, const Ctx& C, int j) {
    const bf16* H = (const bf16*)(P.ws + WS_H); bf16* XM = (bf16*)(P.ws + B_XMIX);
    const float* mu = P.in[21] + (size_t)j * 4 * D; const float* mud = P.in[22] + (size_t)j * 4 * D;
    for (int it = C.gw; it < 2048; it += C.ngw) {
        const int cs = it & 3, r0 = (it >> 2) * 24, c = cs * 512 + 8 * C.lane;
        f32x4 m0[8], m1[8];
#pragma unroll
        for (int i = 0; i < 8; ++i) { const float* mp = (i < 4 ? mu + i * D : mud + (i - 4) * D) + c; m0[i] = *(const f32x4*)mp; m1[i] = *(const f32x4*)(mp + 4); }
        const v4u zero4 = (v4u){0u, 0u, 0u, 0u};
        v4u hp = r0 > 0 ? *(const v4u*)(H + (size_t)(r0 - 1) * D + c) : zero4, hc = *(const v4u*)(H + (size_t)r0 * D + c);
#pragma unroll 4
        for (int i = 0; i < 24; ++i) { const int r = r0 + i;
            const bool isfirst = r < MP ? ((r & 255) == 0) : (((r - MP) & 1023) == 0), islast = r < MP ? ((r & 255) == 255) : (((r - MP) & 1023) == 1023);
            const v4u hn = r + 1 < M ? *(const v4u*)(H + (size_t)(r + 1) * D + c) : zero4;
            const v4u hpu = isfirst ? zero4 : hp, hnu = islast ? zero4 : hn;
            float hv[8], xx[8];
#pragma unroll
            for (int e = 0; e < 4; ++e) { hv[2 * e] = bflo(hc[e]); hv[2 * e + 1] = bfhi(hc[e]);
                xx[2 * e] = 0.5f * (bflo(hpu[e]) + bflo(hnu[e])) - hv[2 * e]; xx[2 * e + 1] = 0.5f * (bfhi(hpu[e]) + bfhi(hnu[e])) - hv[2 * e + 1]; }
#pragma unroll
            for (int k = 0; k < 8; ++k) {
                v4u o; o.x = pk2(hv[0] + xx[0] * m0[k][0], hv[1] + xx[1] * m0[k][1]); o.y = pk2(hv[2] + xx[2] * m0[k][2], hv[3] + xx[3] * m0[k][3]);
                o.z = pk2(hv[4] + xx[4] * m1[k][0], hv[5] + xx[5] * m1[k][1]); o.w = pk2(hv[6] + xx[6] * m1[k][2], hv[7] + xx[7] * m1[k][3]);
                __builtin_nontemporal_store(o, (v4u*)(XM + (size_t)k * M * D + (size_t)r * D + c)); }
            hp = hc; hc = hn;
        }
    }
}

constexpr int SC_STEP = 1536, SC_TC = 4, SC_BUF = SC_TC * SC_STEP, SC_WAVE_LDS = 8192;
template <int R>
__device__ __forceinline__ void scan_chain(const PP& P, const Ctx& C, int j, int row0, int T, int head, int dir, int lat, int seq, int rowbase, bool write_bon) {
    const bf16* Rb = (const bf16*)(P.ws + B_RKV); const bf16* Kb = Rb + (size_t)M * D; const bf16* Vb = Kb + (size_t)M * D;
    const bf16* DEC = (const bf16*)(P.ws + B_DEC) + (size_t)dir * M * D; const bf16* AA = (const bf16*)(P.ws + B_AA) + (size_t)dir * M * D;
    bf16* Y = (bf16*)(P.ws + B_Y) + (size_t)dir * M * D;   float* BON = (float*)(P.ws + B_BON) + (size_t)dir * M * 32;
    const int lane = C.lane, sts = lane >> 4, sq = lane & 15, rg = lane >> 2, jq = lane & 3, irow = rowbase + R * rg;
    LAS unsigned char* buf = C.lds + C.wave * SC_WAVE_LDS;
    const int ch_off = head * 64 + 4 * sq;
    const f32x4 pkk = *(const f32x4*)(P.in[34] + (size_t)j * D + ch_off), pka = *(const f32x4*)(P.in[35] + (size_t)j * D + ch_off), prk = *(const f32x4*)(P.in[36] + (size_t)j * D + ch_off);
    f32x2 s[R][8];
    if (lat) {
#pragma unroll
        for (int rr = 0; rr < R; ++rr) { const float* s0 = (dir ? P.in[5] : P.in[4]) + ((((size_t)seq * 2 + j) * 32 + head) * 64 + irow + rr) * 64 + jq * 16;
#pragma unroll
            for (int e = 0; e < 4; ++e) { const f32x4 x = *(const f32x4*)(s0 + 4 * e); s[rr][2 * e] = (f32x2){x[0], x[1]}; s[rr][2 * e + 1] = (f32x2){x[2], x[3]}; } }
    } else {
#pragma unroll
        for (int rr = 0; rr < R; ++rr)
#pragma unroll
            for (int e = 0; e < 8; ++e) s[rr][e] = (f32x2){0.f, 0.f};
    }
    struct StageRegs { v2u r, k, v, w, a; size_t row; };
    StageRegs gA, gB;
    const int nch = T / SC_TC;
#define SC_LOAD(g, cc) do { const int t_ = dir == 0 ? SC_TC * (cc) + sts : T - SC_TC * ((cc) + 1) + sts; g.row = (size_t)(row0 + t_); const size_t off_ = ((size_t)head * M + g.row) * 64 + 4 * sq; \
        g.r = *(const v2u*)(Rb + off_); g.k = *(const v2u*)(Kb + off_); g.v = *(const v2u*)(Vb + off_); g.w = *(const v2u*)(DEC + off_); g.a = *(const v2u*)(AA + off_); } while (0)
#define SC_WRITE(g) do { const f32x4 fa_ = (f32x4){(float)(g.a.x & 0xffffu), (float)(g.a.x >> 16), (float)(g.a.y & 0xffffu), (float)(g.a.y >> 16)} * (1.0f / 65535.0f), fw_ = (f32x4){(float)(g.w.x & 0xffffu), (float)(g.w.x >> 16), (float)(g.w.y & 0xffffu), (float)(g.w.y >> 16)} * (0.5f / 65535.0f) + 0.5f; const f32x4 fr_ = (f32x4){bflo(g.r.x), bfhi(g.r.x), bflo(g.r.y), bfhi(g.r.y)}, fk_ = (f32x4){bflo(g.k.x), bfhi(g.k.x), bflo(g.k.y), bfhi(g.k.y)}, fv_ = (f32x4){bflo(g.v.x), bfhi(g.v.x), bflo(g.v.y), bfhi(g.v.y)}; const f32x4 kk = fk_ * pkk; float ss = (kk[0] * kk[0] + kk[1] * kk[1]) + (kk[2] * kk[2] + kk[3] * kk[3]); ss = sum16(ss); \
        const float inv = __builtin_amdgcn_rsqf(fmaxf(ss, 1e-24f)); const f32x4 kn = kk * inv; const f32x4 kd = fk_ * ((fa_ - 1.0f) * pka + 1.0f); \
        const f32x4 rb3 = fr_ * kd * prk; float bs = (rb3[0] + rb3[1]) + (rb3[2] + rb3[3]); bs = sum16(bs); \
        if (write_bon && sq == 0) BON[g.row * 32 + head] = bs; \
        LAS float* d_ = (LAS float*)(buf + sts * SC_STEP) + 4 * sq; \
        *(LAS f32x4*)(d_) = -kn; *(LAS f32x4*)(d_ + 64) = fw_; *(LAS f32x4*)(d_ + 128) = kn * fa_; *(LAS f32x4*)(d_ + 192) = kd; *(LAS f32x4*)(d_ + 256) = fr_; *(LAS f32x4*)(d_ + 320) = fv_; } while (0)
    bf16* yb = Y + (size_t)head * M * 64 + irow;
    auto compute_chunk = [&](int cc) __attribute__((always_inline)) {
        const int tbase = dir == 0 ? SC_TC * cc : T - SC_TC * (cc + 1);
        f32x4 xan[4];
        asm volatile("s_waitcnt lgkmcnt(2)" ::: "memory");
        { const LAS float* vp0 = (const LAS float*)(buf + (dir == 0 ? 0 : SC_TC - 1) * SC_STEP) + jq * 16;
#pragma unroll
          for (int e = 0; e < 4; ++e) xan[e] = *(const LAS f32x4*)(vp0 + 4 * e); }
#pragma unroll 2
        for (int st = 0; st < SC_TC; ++st) {
            const int ts = dir == 0 ? st : SC_TC - 1 - st;
            const LAS float* vp = (const LAS float*)(buf + ts * SC_STEP) + jq * 16;
            f32x2 a[8], w[8], b[8], k[8], r[8];
#pragma unroll
            for (int e = 0; e < 4; ++e) { a[2 * e] = (f32x2){xan[e][0], xan[e][1]}; a[2 * e + 1] = (f32x2){xan[e][2], xan[e][3]}; }
#pragma unroll
            for (int e = 0; e < 4; ++e) { const f32x4 xw = *(const LAS f32x4*)(vp + 64 + 4 * e), xb = *(const LAS f32x4*)(vp + 128 + 4 * e);
                w[2 * e] = (f32x2){xw[0], xw[1]}; w[2 * e + 1] = (f32x2){xw[2], xw[3]}; b[2 * e] = (f32x2){xb[0], xb[1]}; b[2 * e + 1] = (f32x2){xb[2], xb[3]}; }
            float vi[R];
            { const LAS float* vv = (const LAS float*)(buf + ts * SC_STEP) + 320 + irow;
              if (R == 4) { const f32x4 x = *(const LAS f32x4*)vv; vi[0] = x[0]; vi[1] = x[1]; vi[R - 2] = x[2]; vi[R - 1] = x[3]; }
              else { const f32x2 x = *(const LAS f32x2*)vv; vi[0] = x[0]; vi[1] = x[1]; } }
            float sa_[R];
#pragma unroll
            for (int rr = 0; rr < R; ++rr) {
                f32x2 sa2 = s[rr][0] * a[0], sa3 = s[rr][1] * a[1];
#pragma unroll
                for (int e = 2; e < 8; e += 2) { sa2 = s[rr][e] * a[e] + sa2; sa3 = s[rr][e + 1] * a[e + 1] + sa3; }
                sa2 = sa2 + sa3;
                sa_[rr] = quad_sum(sa2[0] + sa2[1]);
            }
            if (R == 4) asm volatile("s_waitcnt lgkmcnt(2)" : "+v"(sa_[0]), "+v"(sa_[1]), "+v"(sa_[R - 2]), "+v"(sa_[R - 1]) :: "memory");
            else asm volatile("s_waitcnt lgkmcnt(2)" : "+v"(sa_[0]), "+v"(sa_[1]) :: "memory");
#pragma unroll
            for (int e = 0; e < 4; ++e) { const f32x4 xk = *(const LAS f32x4*)(vp + 192 + 4 * e), xr = *(const LAS f32x4*)(vp + 256 + 4 * e);
                k[2 * e] = (f32x2){xk[0], xk[1]}; k[2 * e + 1] = (f32x2){xk[2], xk[3]}; r[2 * e] = (f32x2){xr[0], xr[1]}; r[2 * e + 1] = (f32x2){xr[2], xr[3]}; }
            if (st + 1 < SC_TC) { const LAS float* vpn = (const LAS float*)(buf + (dir == 0 ? st + 1 : SC_TC - 2 - st) * SC_STEP) + jq * 16;
#pragma unroll
                for (int e = 0; e < 4; ++e) xan[e] = *(const LAS f32x4*)(vpn + 4 * e); }
            float yo[R];
#pragma unroll
            for (int rr = 0; rr < R; ++rr) {
                const f32x2 sav = (f32x2){sa_[rr], sa_[rr]};
#pragma unroll
                for (int e = 0; e < 8; ++e) s[rr][e] = s[rr][e] * w[e] + b[e] * sav;
            }
#pragma unroll
            for (int rr = 0; rr < R; ++rr) {
                const f32x2 vv2 = (f32x2){vi[rr], vi[rr]};
                f32x2 y2 = (f32x2){0.f, 0.f}, y3 = (f32x2){0.f, 0.f};
#pragma unroll
                for (int e = 0; e < 8; e += 2) { s[rr][e] = k[e] * vv2 + s[rr][e]; s[rr][e + 1] = k[e + 1] * vv2 + s[rr][e + 1];
                    y2 = s[rr][e] * r[e] + y2; y3 = s[rr][e + 1] * r[e + 1] + y3; }
                y2 = y2 + y3;
                yo[rr] = quad_sum(y2[0] + y2[1]);
            }
            if (jq == 0) { bf16* yp = yb + (size_t)(row0 + tbase + ts) * 64;
                if (R == 4) { v2u w; w.x = pg8::cvt_pk_bf16(yo[0], yo[1]); w.y = pg8::cvt_pk_bf16(yo[R - 2], yo[R - 1]); *(v2u*)yp = w; } else *(unsigned*)yp = pg8::cvt_pk_bf16(yo[0], yo[1]); }
        }
    };
    SC_LOAD(gA, 0); SC_WRITE(gA);
    SC_LOAD(gA, 1);
#pragma unroll 1
    for (int cc = 0; cc < nch; cc += 2) {
        if (cc + 2 < nch) SC_LOAD(gB, cc + 2);
        compute_chunk(cc);
        SC_WRITE(gA);
        if (cc + 3 < nch) SC_LOAD(gA, cc + 3);
        compute_chunk(cc + 1);
        if (cc + 2 < nch) SC_WRITE(gB);
    }
#undef SC_LOAD
#undef SC_WRITE
    if (!lat) {
#pragma unroll
        for (int rr = 0; rr < R; ++rr) { float* so = P.out + (dir ? O_SB : O_SF) + ((((size_t)seq * 2 + j) * 32 + head) * 64 + irow + rr) * 64 + jq * 16;
#pragma unroll
            for (int e = 0; e < 4; ++e) *(f32x4*)(so + 4 * e) = (f32x4){s[rr][2 * e][0], s[rr][2 * e][1], s[rr][2 * e + 1][0], s[rr][2 * e + 1][1]}; }
    }
}
__device__ __forceinline__ void phase_scan(const PP& P, const Ctx& C, int j, int late_set) {
    for (int vc = C.vcu; vc < 256; vc += C.G) {
        if (C.wave < 2) {
            __builtin_amdgcn_s_setprio(2);
            scan_chain<2>(P, C, j, MP + (vc >> 6) * 1024, 1024, (vc >> 1) & 31, vc & 1, 1, vc >> 6, 32 * C.wave, C.wave == 0);
            __builtin_amdgcn_s_setprio(0);
        } else {
            const int m0 = C.wave < 4 ? 2 * (C.wave - 2) : C.wave, nm = C.wave < 4 ? 2 : 1;
#pragma unroll 1
            for (int q = 0; q < nm; ++q) { const int cidx = 8 * vc + m0 + q; scan_chain<4>(P, C, j, (cidx >> 6) * 256, 256, (cidx >> 1) & 31, cidx & 1, 0, cidx >> 6, 0, true); }
        }
    }
    if (late_set >= 0 && C.wave >= 4) {
        LAS float* scr = (LAS float*)(C.lds + 65536 + (C.wave - 4) * 16640);
        const int nlw = C.G * 4;
        const int nlate = late_set == 0 ? IT_LATE_A : IT_LATE_B;
        for (int t = C.vcu * 4 + (C.wave - 4); t < nlate; t += nlw) { TJob J; int item; make_job(P, late_item(t, late_set), J, item); transpose_item(J, item, scr, C.lane); }
    }
}
__device__ __forceinline__ void phase_post(const PP& P, const Ctx& C, int j) {
    const bf16* Y = (const bf16*)(P.ws + B_Y); const float* BON = (const float*)(P.ws + B_BON); const bf16* Vb = (const bf16*)(P.ws + B_RKV) + (size_t)2 * M * D; const bf16* G = (const bf16*)(P.ws + B_G);
    bf16* O2 = (bf16*)(P.ws + B_O2);
    const float* lnw = P.in[37] + (size_t)j * D; const float* lnb = P.in[38] + (size_t)j * D;
    const int hs = C.lane >> 4, q = C.lane & 15;
    for (int r = C.gw; r < M; r += C.ngw) {
        f32x4 yf[8], yb[8], vv[8], gg[8]; float b0[8], b1[8];
#pragma unroll
        for (int p = 0; p < 8; ++p) { const int head = p * 4 + hs; const size_t off = (size_t)r * D + head * 64 + 4 * q;
            const size_t hoff = ((size_t)head * M + r) * 64 + 4 * q;
            { const v2u a_ = *(const v2u*)(Y + hoff), b_ = *(const v2u*)(Y + (size_t)M * D + hoff); yf[p] = (f32x4){bflo(a_.x), bfhi(a_.x), bflo(a_.y), bfhi(a_.y)}; yb[p] = (f32x4){bflo(b_.x), bfhi(b_.x), bflo(b_.y), bfhi(b_.y)}; } { const v2u v_ = *(const v2u*)(Vb + hoff); vv[p] = (f32x4){bflo(v_.x), bfhi(v_.x), bflo(v_.y), bfhi(v_.y)}; } { const v2u gw_ = *(const v2u*)(G + off); gg[p] = (f32x4){bflo(gw_.x), bfhi(gw_.x), bflo(gw_.y), bfhi(gw_.y)}; }
            b0[p] = BON[(size_t)r * 32 + head]; b1[p] = BON[((size_t)M + r) * 32 + head]; }
#pragma unroll
        for (int p = 0; p < 8; ++p) { const int head = p * 4 + hs, c = head * 64 + 4 * q; const size_t off = (size_t)r * D + c;
            const f32x4 y = yf[p] + yb[p];
            const float mean = sum16((y[0] + y[1]) + (y[2] + y[3])) * (1.0f / 64);
            const f32x4 d = y - mean;
            const float var = sum16((d[0] * d[0] + d[1] * d[1]) + (d[2] * d[2] + d[3] * d[3])) * (1.0f / 64);
            const float rs = __builtin_amdgcn_rsqf(var + GN_EPS);
            const f32x4 o = (d * rs * *(const f32x4*)(lnw + c) + *(const f32x4*)(lnb + c) + vv[p] * (b0[p] + b1[p])) * gg[p];
            v2u w; w.x = pk2(o[0], o[1]); w.y = pk2(o[2], o[3]); *(v2u*)(O2 + off) = w; }
    }
}

__device__ __forceinline__ Ctx make_ctx(LAS unsigned char* lds, int wave0) {
    Ctx C; C.lds = lds; C.lane = pg8::lane_id_v(); C.wave = wave0; C.tid = C.wave * 64 + C.lane;
    const int bx = opaque_s((int)blockIdx.x); C.G = opaque_s((int)gridDim.x); C.vcu = (C.G % 8 == 0) ? (bx % 8) * (C.G / 8) + bx / 8 : bx;
    C.gw = C.vcu * NWAVES + C.wave; C.ngw = C.G * NWAVES; return C;
}
__global__ void __launch_bounds__(NTHR, 2) fwd_kernel(Params K) {
    extern __shared__ __attribute__((aligned(16))) unsigned char lds_raw[];
    LAS unsigned char* const lds0 = (LAS unsigned char*)lds_raw;
    volatile LAS unsigned* MISC = (volatile LAS unsigned*)(lds0 + MISC_OFF);
    if (threadIdx.x < 64) MISC[threadIdx.x] = 0u;
    __syncthreads();
    (void)xcd_barrier_post((unsigned*)(K.ws + WS_CTL) + CW_BAR, MISC + 8);
    const int wave0 = __builtin_amdgcn_readfirstlane((int)threadIdx.x >> 6);
    const int lo = K.ph_lo, hi = K.ph_hi; int pidx = 0;
#ifndef PHMASK
#define PHMASK 0xFFFFFFFFu
#endif
#define EN(n) (((PHMASK) >> (n)) & 1u)
#ifndef DUPMASK
#define DUPMASK 0u
#endif
#define NREP(n) ((((DUPMASK) >> (n)) & 1u) ? 2 : 1)
#define PH_BEGIN(n) if (EN(n) && lo <= pidx && pidx < hi) { for (int rep_ = 0; rep_ < NREP(n); ++rep_) { const bool dup_first = NREP(n) > 1 && opaque_s(rep_) == 0; (void)dup_first; const PP P = make_pp(); const Ctx C = make_ctx(lds0, wave0); unsigned char* const ws = P.ws; float* const modb = (float*)(ws + WS_MOD); bf16* const X = (bf16*)(ws + WS_X); (void)modb; (void)X; (void)C;
#define PH_END if (pidx + 1 < hi || dup_first) { XcdBarrier b_; b_.bar = (unsigned*)(ws + WS_CTL) + CW_BAR; b_.x = xb_xcc_id(); b_.lead = (wave0 == 0 && pg8::lane_id_v() == 0) ? 1u : 0u; b_.st = (volatile LAS unsigned*)(lds0 + MISC_OFF) + 8; xcd_barrier(b_); } } } ++pidx;

    PH_BEGIN(0) p0_prologue(P, C); PH_END

    for (int l = 0; l < 4; ++l) {
        const int j = l >> 1;
        for (int half = 0; half < 2; ++half) {
            PH_BEGIN(1) phase_norm(P, C, l, half * 2); PH_END
            PH_BEGIN(2) { const char* A_ = (const char*)(ws + WS_H); const char* B_ = (const char*)(ws + WS_WFI) + (size_t)(l * 2 + half) * NFI * D * 2;
                { pg8::SchedFa S; S.A = A_; S.B = B_; S.G = C.G; S.c = opaque_s((int)blockIdx.x); S.tstep = (size_t)256 * D * 2;
                  pg8::EpiSwigluT<4> E{(bf16*)(ws + WS_U)};
                  pg8::gemm_phase<pg8::EpiSwigluT<4>, pg8::SchedFa, true, true, 4>(C.lds, D, S, E, C.tid); }
                { pg8::SchedFb S; S.A = A_; S.B = B_; S.G = C.G; S.c = opaque_s((int)blockIdx.x); S.tstep = (size_t)256 * D * 2;
                  pg8::EpiSwigluT<1> E{(bf16*)(ws + WS_U)};
                  pg8::gemm_phase<pg8::EpiSwigluT<1>, pg8::SchedFb, true, true, 1>(C.lds, D, S, E, C.tid); } } PH_END
            PH_BEGIN(3) { pg8::Sched1 S; S.A = (const char*)(ws + WS_U); S.B = (const char*)(ws + WS_WFO) + (size_t)(l * 2 + half) * D * DFF * 2; S.nM = M / 192; S.nN = D / 256; S.G = C.G; S.c = opaque_s((int)blockIdx.x); S.tstep = (size_t)192 * DFF * 2; S.tstepB = (size_t)256 * DFF * 2;
                pg8::EpiResidT<3> E{X, modb + (size_t)l * 5 * 18432 + (half ? 8 : 2) * D, dup_first ? 0.f : 0.5f};
                pg8::gemm_phase<pg8::EpiResidT<3>, pg8::Sched1, true, true, 3>(C.lds, DFF, S, E, C.tid); } PH_END
            if (half == 0) {
                PH_BEGIN(1) phase_norm(P, C, l, 1); PH_END
                if ((l & 1) == 0) {
#define wb (ws + WS_WMLA + (size_t)j * 20 * MiB)
                    PH_BEGIN(4) { pg8::Sched1 S; S.A = (const char*)(ws + WS_H); S.B = (const char*)wb; S.nM = M / 256; S.nN = 5; S.G = C.G; S.c = opaque_s((int)blockIdx.x); S.tstep = (size_t)256 * D * 2; S.tstepB = S.tstep;
                        pg8::EpiF32 E{(float*)(ws + A_RAW), 1280};
                        pg8::gemm_phase<pg8::EpiF32, pg8::Sched1, true, true>(C.lds, D, S, E, C.tid); } PH_END
                    PH_BEGIN(5) phase_mla_norm(P, C, j); PH_END
                    PH_BEGIN(6) { pg8::SchedM3 S; S.A0 = (const char*)(ws + A_CQ); S.B0 = (const char*)(wb + 5 * MiB); S.A1 = (const char*)(ws + A_CKV); S.B1 = (const char*)(wb + 8 * MiB);
                        S.nM0 = M / 256; S.nN0 = 12; S.nM1 = KVROWS / 256; S.nN1 = 16; S.G = C.G; S.c = opaque_s((int)blockIdx.x); S.tstep = (size_t)256 * 512 * 2;
                        pg8::EpiM3 E{(bf16*)(ws + A_Q), (bf16*)(ws + A_KV)};
                        pg8::gemm_phase<pg8::EpiM3, pg8::SchedM3, true, true>(C.lds, 512, S, E, C.tid); } PH_END
                    PH_BEGIN(8) phase_attn(P, C); PH_END
                    PH_BEGIN(9) { pg8::Sched1 S; S.A = (const char*)(ws + A_O); S.B = (const char*)(wb + 12 * MiB); S.nM = M / 192; S.nN = D / 256; S.G = C.G; S.c = opaque_s((int)blockIdx.x); S.tstep = (size_t)192 * D * 2; S.tstepB = (size_t)256 * D * 2;
                        pg8::EpiResidT<3> E{X, modb + (size_t)l * 5 * 18432 + 5 * D, dup_first ? 0.f : 1.0f};
                        pg8::gemm_phase<pg8::EpiResidT<3>, pg8::Sched1, true, true, 3>(C.lds, D, S, E, C.tid); } PH_END
                } else {
#undef wb
#define wb (ws + WS_WRW + (size_t)j * 42 * MiB)
                    PH_BEGIN(10) phase_shift(P, C, j); PH_END
                    PH_BEGIN(11) { pg8::SchedR2 S; S.A = (const char*)(ws + B_XMIX); S.B = (const char*)wb; S.nM = M / 256; S.G = C.G; S.c = opaque_s((int)blockIdx.x); S.tstep = (size_t)256 * D * 2; S.astride = (size_t)M * D * 2;
                        pg8::EpiR2 E{(bf16*)(ws + B_RKV), (size_t)M * D, (bf16*)(ws + B_T1), (size_t)M * 256, (size_t)M};
                        pg8::gemm_phase<pg8::EpiR2, pg8::SchedR2, true, true>(C.lds, D, S, E, C.tid); } PH_END
                    PH_BEGIN(12) { pg8::SchedR3 S; S.A = (const char*)(ws + B_T1); S.B = (const char*)(wb + 29 * MiB); S.nM = M / 256; S.G = C.G; S.c = opaque_s((int)blockIdx.x); S.tstep = (size_t)256 * 256 * 2; S.astride = (size_t)M * 256 * 2;
                        pg8::EpiR3 E{(bf16*)(ws + B_G), (bf16*)(ws + B_DEC), (bf16*)(ws + B_AA), (size_t)M * D, P.in[26] + (size_t)j * 2 * D, P.in[29] + (size_t)j * 2 * D, (size_t)M};
                        pg8::gemm_phase<pg8::EpiR3, pg8::SchedR3, true, true>(C.lds, 256, S, E, C.tid); } PH_END
                    PH_BEGIN(13) phase_scan(P, C, j, dup_first ? -1 : (l == 1 ? 0 : 1)); PH_END
                    PH_BEGIN(14) phase_post(P, C, j); PH_END
                    PH_BEGIN(15) { pg8::Sched1 S; S.A = (const char*)(ws + B_O2); S.B = (const char*)(wb + 34 * MiB); S.nM = M / 192; S.nN = D / 256; S.G = C.G; S.c = opaque_s((int)blockIdx.x); S.tstep = (size_t)192 * D * 2; S.tstepB = (size_t)256 * D * 2;
                        pg8::EpiResidT<3> E{X, modb + (size_t)l * 5 * 18432 + 5 * D, dup_first ? 0.f : 1.0f};
                        pg8::gemm_phase<pg8::EpiResidT<3>, pg8::Sched1, true, true, 3>(C.lds, D, S, E, C.tid); } PH_END
                }
            }
        }
    }
    PH_BEGIN(16) phase_final(P, C); PH_END
#undef PH_BEGIN
#undef wb
#undef PH_END
}

#ifndef MK_PER_PHASE
#define MK_PER_PHASE 0
#endif
constexpr int N_PHASES = 52;
extern "C" void kernel_launch(void* const* d_in, const int* in_sizes, int n_in, void* d_out, int out_size, void* d_ws, size_t ws_size, hipStream_t stream) {
    static int grid = 0;
    if (grid == 0) {
        if (n_in != 40 || out_size != (int)O_END || ws_size < WS_END) { fprintf(stderr, "kernel_launch: unexpected problem (n_in %d, out %d, ws %zu; need ws >= %zu); nothing launched\n", n_in, out_size, ws_size, (size_t)WS_END); grid = -1; return; }
        int dev = 0, cus = 0, per_cu = 0;
        if (hipGetDevice(&dev) != hipSuccess || hipDeviceGetAttribute(&cus, hipDeviceAttributeMultiprocessorCount, dev) != hipSuccess) { grid = -1; return; }
        if (hipFuncSetAttribute((const void*)fwd_kernel, hipFuncAttributeMaxDynamicSharedMemorySize, LDS_BYTES) != hipSuccess) { fprintf(stderr, "kernel_launch: hipFuncSetAttribute failed\n"); grid = -1; return; }
        if (hipOccupancyMaxActiveBlocksPerMultiprocessor(&per_cu, (const void*)fwd_kernel, NTHR, LDS_BYTES) != hipSuccess || per_cu < 1) { fprintf(stderr, "kernel_launch: occupancy query says %d\n", per_cu); }
        (void)hipGetLastError();
        grid = cus > 256 ? 256 : cus;
    }
    if (grid < 0) return;
    (void)hipMemsetAsync((char*)d_ws + WS_CTL, 0, CTL_ZERO_BYTES, stream);
    Params p{};
    for (int i = 0; i < 40; ++i) p.in[i] = (const float*)d_in[i];
    p.out = (float*)d_out; p.ws = (unsigned char*)d_ws;
#if MK_PER_PHASE
    for (int li = 0; li < N_PHASES; ++li) { p.ph_lo = li; p.ph_hi = li + 1; hipLaunchKernelGGL(fwd_kernel, dim3(grid), dim3(NTHR), LDS_BYTES, stream, p); }
#else
    p.ph_lo = 0; p.ph_hi = N_PHASES;
    hipLaunchKernelGGL(fwd_kernel, dim3(grid), dim3(NTHR), LDS_BYTES, stream, p);
#endif
}
```

```cpp
#include <hip/hip_runtime.h>
#include <cstdio>
#include <cstdint>
namespace pg8 {
#define PG8_LAS __attribute__((address_space(3)))
typedef unsigned short bf16_t;
typedef short bf16x8 __attribute__((ext_vector_type(8)));
typedef float f32x4 __attribute__((ext_vector_type(4)));
typedef unsigned u32x4 __attribute__((ext_vector_type(4)));
constexpr int BM = 256, BK = 64, HALF = 128, HTB = HALF * BK * 2  , STAGE_BYTES = 8 * HTB, NXCD = 8, WGM = 8;

__host__ __device__ __forceinline__ int lds_byte(int r, int c) { const int st = (r >> 4) * 2 + (c >> 5), rr = r & 15, cc = c & 31, ob = rr * 64 + cc * 2; return st * 1024 + (ob ^ (((ob >> 9) & 1) << 5)); }
__host__ __device__ __forceinline__ void stage_rc(int b, int& R, int& C) { const int st = b / 1024, sb = b % 1024, swz = sb ^ (((sb >> 9) & 1) << 5); R = (st >> 1) * 16 + swz / 64; C = (st & 1) * 32 + (swz % 64) / 2; }
__host__ __device__ __forceinline__ int perm32(int rho) { const int n = rho >> 4, i = rho & 15; return 8 * (i >> 2) + 4 * n + (i & 3); }

struct Unit { int pm, pn, g; };

__device__ __forceinline__ void tile_of(int L, int nM, int nN, int& pm, int& pn) {
    const int nwg = nM * nN; int wgid = L; { const int q = nwg / NXCD, r = nwg % NXCD, xcd = wgid % NXCD, off = wgid / NXCD; wgid = (xcd < r ? xcd * (q + 1) : r * (q + 1) + (xcd - r) * q) + off; }
    const int nig = WGM * nN, gid = wgid / nig, fm = gid * WGM, gsz = (nM - fm) < WGM ? (nM - fm) : WGM;
    pm = fm + ((wgid % nig) % gsz); pn = (wgid % nig) / gsz;
}
__device__ __forceinline__ int opaque_v(int x) { asm volatile("" : "+v"(x)); return x; }
__device__ __forceinline__ int opaque_s(int x) { asm volatile("" : "+v"(x)); return __builtin_amdgcn_readfirstlane(x); }
__device__ __forceinline__ int lane_id_v() { int l; asm volatile("v_mbcnt_lo_u32_b32 %0, -1, 0\n\tv_mbcnt_hi_u32_b32 %0, -1, %0" : "=v"(l)); return l; }
template <class Epi, class Sched, bool ALIGN_EPI = false, bool SP2 = false, int MB = 4>
__device__ __forceinline__ void gemm_phase(PG8_LAS unsigned char* lds, const int K, const Sched& S, const Epi& E, const int tid_in) {
    const int tid = opaque_v(tid_in), wid = __builtin_amdgcn_readfirstlane(tid >> 6), lane = tid & 63, wr = wid >> 2, wc = wid & 3, fr = lane & 15, fq = lane >> 4;
    const int nt = K / BK;
    unsigned voffA[2], voffB[2];
#pragma unroll
    for (int i = 0; i < 2; ++i) { int R, C; stage_rc(tid * 16 + i * 8192, R, C); const int Rb = Epi::PERM ? ((R & ~31) + perm32(R & 31)) : R;
        const int mR = (R >> 4) & 3, Ra = MB == 4 ? R : (R >> 6) * (16 * MB) + (mR < MB ? mR : MB - 1) * 16 + (R & 15);
        voffA[i] = (unsigned)(Ra * K + C) * 2u; voffB[i] = (unsigned)(Rb * K + C) * 2u; }
    const size_t kstep = (size_t)(BK * 2);
    const size_t hstep = (size_t)HALF * K * 2;
    const size_t hstepA = (size_t)(32 * MB) * K * 2;
    const unsigned ldsw = (unsigned)wid * 1024u;
    const int aoff = lds_byte(wr * 64 + fr, fq * 8), boff = lds_byte(wc * 32 + fr, fq * 8);
#define PG8_SA(b, h) (((b) * 2 + (h)) * HTB)
#define PG8_SB(b, h) ((4 + (b) * 2 + (h)) * HTB)
#define PG8_STAGE(bufoff, gbase, voff) do { _Pragma("unroll") for (int _i = 0; _i < 2; ++_i) \
        __builtin_amdgcn_global_load_lds((const unsigned*)((const char*)(gbase) + (voff)[_i]), (PG8_LAS unsigned*)(lds + (bufoff) + ldsw + _i * 8192), 16, 0, 0); } while (0)
#define PG8_LDA(dst, b, h) do { _Pragma("unroll") for (int m = 0; m < MB; ++m) _Pragma("unroll") for (int k = 0; k < 2; ++k) dst[m][k] = *(const PG8_LAS bf16x8*)(lds + PG8_SA(b, h) + aoff + m * 2048 + k * 1024); } while (0)
#define PG8_LDB(dst, b, h) do { _Pragma("unroll") for (int n = 0; n < 2; ++n) _Pragma("unroll") for (int k = 0; k < 2; ++k) dst[n][k] = *(const PG8_LAS bf16x8*)(lds + PG8_SB(b, h) + boff + n * 2048 + k * 1024); } while (0)
#define PG8_MMA(ai, bj, At, Bt) do { __builtin_amdgcn_s_setprio(1); _Pragma("unroll") for (int m = 0; m < MB; ++m) _Pragma("unroll") for (int n = 0; n < 2; ++n) _Pragma("unroll") for (int k = 0; k < 2; ++k) \
        acc[ai][bj][m][n] = __builtin_amdgcn_mfma_f32_16x16x32_bf16(Bt[n][k], At[m][k], acc[ai][bj][m][n], 0, 0, 0); __builtin_amdgcn_s_setprio(0); } while (0)
#define PG8_WAIT_V(n) asm volatile("s_waitcnt vmcnt(" #n ")" ::: "memory")
#define PG8_WAIT_L(n) asm volatile("s_waitcnt lgkmcnt(" #n ")" ::: "memory")
#define PG8_BAR __builtin_amdgcn_s_barrier()
#define PG8_SCHED __builtin_amdgcn_sched_barrier(0)
    Unit cur, nxt; int ui = 0;
    if (!S.next(0, cur)) return;
    f32x4 acc[2][2][MB][2];
#pragma unroll
    for (int a = 0; a < 2; ++a)
#pragma unroll
        for (int b = 0; b < 2; ++b)
#pragma unroll
            for (int m = 0; m < MB; ++m)
#pragma unroll
                for (int n = 0; n < 2; ++n) acc[a][b][m][n] = (f32x4){0.f, 0.f, 0.f, 0.f};
    bf16x8 At[MB][2], B0[2][2], B1[2][2];
    const char* cA = S.a_ptr(cur); const char* cB = S.b_ptr(cur);
    S.a_ready(cur);
    if constexpr (SP2) {
        PG8_STAGE(PG8_SB(0, 0), cB, voffB); PG8_STAGE(PG8_SB(0, 1), cB + hstep, voffB); PG8_STAGE(PG8_SA(0, 0), cA, voffA); PG8_STAGE(PG8_SA(0, 1), cA + hstepA, voffA);
        if (wr == 1) PG8_BAR;
        PG8_WAIT_V(2); PG8_BAR;
        PG8_STAGE(PG8_SB(1, 0), cB + kstep, voffB); PG8_STAGE(PG8_SA(1, 0), cA + kstep, voffA); PG8_STAGE(PG8_SB(1, 1), cB + hstep + kstep, voffB);
        PG8_WAIT_V(6); PG8_BAR;
    } else {
        PG8_STAGE(PG8_SB(0, 0), cB, voffB); PG8_STAGE(PG8_SA(0, 0), cA, voffA); PG8_STAGE(PG8_SB(0, 1), cB + hstep, voffB); PG8_STAGE(PG8_SA(0, 1), cA + hstepA, voffA);
        if (wr == 1) PG8_BAR;
        PG8_WAIT_V(4); PG8_BAR;
        PG8_STAGE(PG8_SB(1, 0), cB + kstep, voffB); PG8_STAGE(PG8_SA(1, 0), cA + kstep, voffA); PG8_STAGE(PG8_SB(1, 1), cB + hstep + kstep, voffB);
        PG8_WAIT_V(6); PG8_BAR;
    }
    for (;;) {
        const bool has_next = S.next(ui + 1, nxt);
        const char* nA = has_next ? S.a_ptr(nxt) : cA; const char* nB = has_next ? S.b_ptr(nxt) : cB;
        for (int t = 0; t < nt; t += 2) {
            const bool last = (t == nt - 2);
            const char* a1 = cA + (size_t)(t + 1) * kstep;
            const char* a2 = last ? nA : cA + (size_t)(t + 2) * kstep; const char* b2 = last ? nB : cB + (size_t)(t + 2) * kstep;
            const char* a3 = a2 + kstep; const char* b3 = b2 + kstep;
            if (last && has_next) S.a_ready(nxt);
            if constexpr (SP2) {
            PG8_LDB(B0, 0, 0); PG8_LDB(B1, 0, 1); PG8_SCHED; PG8_LDA(At, 0, 0); PG8_STAGE(PG8_SA(1, 1), a1 + hstepA, voffA);
            PG8_WAIT_V(8); PG8_WAIT_L(0); PG8_BAR; PG8_MMA(0, 0, At, B0); PG8_MMA(0, 1, At, B1); PG8_BAR; PG8_SCHED;
            PG8_LDA(At, 0, 1); PG8_STAGE(PG8_SB(0, 0), b2, voffB); PG8_STAGE(PG8_SB(0, 1), b2 + hstep, voffB); PG8_STAGE(PG8_SA(0, 0), a2, voffA);
            PG8_WAIT_V(8); PG8_WAIT_L(0); PG8_BAR; PG8_MMA(1, 0, At, B0); PG8_MMA(1, 1, At, B1); PG8_BAR; PG8_SCHED;
            PG8_LDB(B0, 1, 0); PG8_LDB(B1, 1, 1); PG8_SCHED; PG8_LDA(At, 1, 0); PG8_STAGE(PG8_SA(0, 1), a2 + hstepA, voffA);
            PG8_WAIT_V(8); PG8_WAIT_L(0); PG8_BAR; PG8_MMA(0, 0, At, B0); PG8_MMA(0, 1, At, B1); PG8_BAR; PG8_SCHED;
            PG8_LDA(At, 1, 1); PG8_STAGE(PG8_SB(1, 0), b3, voffB); PG8_STAGE(PG8_SB(1, 1), b3 + hstep, voffB); PG8_STAGE(PG8_SA(1, 0), a3, voffA);
            PG8_WAIT_V(8); PG8_WAIT_L(0); PG8_BAR; PG8_MMA(1, 0, At, B0); PG8_MMA(1, 1, At, B1); PG8_BAR; PG8_SCHED;
            } else {
            PG8_LDB(B0, 0, 0); PG8_SCHED; PG8_LDA(At, 0, 0); PG8_STAGE(PG8_SA(1, 1), a1 + hstepA, voffA);
            PG8_WAIT_L(8); PG8_BAR; PG8_WAIT_L(0); PG8_MMA(0, 0, At, B0); PG8_BAR; PG8_SCHED;
            PG8_LDB(B1, 0, 1); PG8_STAGE(PG8_SB(0, 0), b2, voffB);
            PG8_BAR; PG8_WAIT_L(0); PG8_MMA(0, 1, At, B1); PG8_BAR;
            PG8_LDA(At, 0, 1); PG8_STAGE(PG8_SA(0, 0), a2, voffA);
            PG8_BAR; PG8_WAIT_L(0); PG8_MMA(1, 0, At, B0); PG8_BAR; PG8_SCHED;
            PG8_STAGE(PG8_SB(0, 1), b2 + hstep, voffB);
            PG8_WAIT_V(6); PG8_BAR; PG8_MMA(1, 1, At, B1); PG8_BAR;
            PG8_LDB(B0, 1, 0); PG8_SCHED; PG8_LDA(At, 1, 0); PG8_STAGE(PG8_SA(0, 1), a2 + hstepA, voffA);
            PG8_WAIT_L(8); PG8_BAR; PG8_WAIT_L(0); PG8_MMA(0, 0, At, B0); PG8_BAR; PG8_SCHED;
            PG8_LDB(B1, 1, 1); PG8_STAGE(PG8_SB(1, 0), b3, voffB);
            PG8_BAR; PG8_WAIT_L(0); PG8_MMA(0, 1, At, B1); PG8_BAR;
            PG8_LDA(At, 1, 1); PG8_STAGE(PG8_SA(1, 0), a3, voffA);
            PG8_BAR; PG8_WAIT_L(0); PG8_MMA(1, 0, At, B0); PG8_BAR; PG8_SCHED;
            PG8_STAGE(PG8_SB(1, 1), b3 + hstep, voffB);
            PG8_WAIT_V(6); PG8_BAR; PG8_MMA(1, 1, At, B1); PG8_BAR;
            }
        }
        if constexpr (ALIGN_EPI) { if (wr == 0) PG8_BAR; }
        if constexpr (!Epi::AFTER_DRAIN) { E(acc, cur, wr, wc, fr, fq); S.done(cur); }
        if (!has_next) break;
#pragma unroll
        for (int a = 0; a < 2; ++a)
#pragma unroll
            for (int b = 0; b < 2; ++b)
#pragma unroll
                for (int m = 0; m < MB; ++m)
#pragma unroll
                    for (int n = 0; n < 2; ++n) acc[a][b][m][n] = (f32x4){0.f, 0.f, 0.f, 0.f};
        cur = nxt; cA = nA; cB = nB; ++ui;
        if constexpr (ALIGN_EPI) { if (wr == 1) PG8_BAR; }
    }
    PG8_WAIT_V(0);
    if constexpr (!ALIGN_EPI) { if (wr == 0) PG8_BAR; }
    PG8_BAR;
    if constexpr (Epi::AFTER_DRAIN) { E.fused(acc, cur, wr, wc, fr, fq, lds, wid, lane); S.done(cur); }
#undef PG8_SA
#undef PG8_SB
#undef PG8_STAGE
#undef PG8_LDA
#undef PG8_LDB
#undef PG8_MMA
#undef PG8_WAIT_V
#undef PG8_WAIT_L
#undef PG8_BAR
#undef PG8_SCHED
}

struct SchedBase { __device__ __forceinline__ void a_ready(const Unit&) const {} __device__ __forceinline__ void done(const Unit&) const {} };
struct Sched1 : SchedBase {
    const char* A; const char* B; int nM, nN, G, c; size_t tstep, tstepB;
    __device__ __forceinline__ bool next(int i, Unit& u) const { const long L = (long)i * G + c; if (L >= (long)nM * nN) return false; tile_of((int)L, nM, nN, u.pm, u.pn); u.g = 0; return true; }
    __device__ __forceinline__ const char* a_ptr(const Unit& u) const { return A + (size_t)u.pm * tstep; }
    __device__ __forceinline__ const char* b_ptr(const Unit& u) const { return B + (size_t)u.pn * tstepB; }
};
struct SchedFa : SchedBase {
    const char* A; const char* B; int G, c; size_t tstep;
    __device__ __forceinline__ bool next(int i, Unit& u) const { const long L = (long)i * G + c; if (L >= 2048) return false; if (L < 2024) tile_of((int)L, 46, 44, u.pm, u.pn); else { u.pm = 46; u.pn = (int)L - 2024; } u.g = 0; return true; }
    __device__ __forceinline__ const char* a_ptr(const Unit& u) const { return A + (size_t)u.pm * tstep; }
    __device__ __forceinline__ const char* b_ptr(const Unit& u) const { return B + (size_t)u.pn * tstep; }
};
struct SchedFb : SchedBase {
    const char* A; const char* B; int G, c; size_t tstep;
    __device__ __forceinline__ bool next(int i, Unit& u) const { const long L0 = (long)i * G + c; if (L0 >= 256) return false;
        const int L = ((int)L0 & 7) * 32 + ((int)L0 >> 3);
        if (L < 80) { u.pn = 24 + (L >> 2); u.pm = 46 * 4 + (L & 3); } else { const int L1 = L - 80; u.pn = L1 >> 2; u.pm = 47 * 4 + (L1 & 3); } u.g = 0; return true; }
    __device__ __forceinline__ const char* a_ptr(const Unit& u) const { return A + (size_t)u.pm * (tstep >> 2); }
    __device__ __forceinline__ const char* b_ptr(const Unit& u) const { return B + (size_t)u.pn * tstep; }
};
struct SchedR2 : SchedBase {
    const char* A; const char* B; int nM, G, c; size_t tstep, astride;
    __device__ __forceinline__ bool next(int i, Unit& u) const { const long L = (long)i * G + c; if (L >= (long)nM * 29) return false; tile_of((int)L, nM, 29, u.pm, u.pn); u.g = u.pn < 24 ? (u.pn >> 3) : (u.pn - 21); return true; }
    __device__ __forceinline__ const char* a_ptr(const Unit& u) const { return A + (size_t)u.g * astride + (size_t)u.pm * tstep; }
    __device__ __forceinline__ const char* b_ptr(const Unit& u) const { return B + (size_t)u.pn * tstep; }
};
struct SchedR3 : SchedBase {
    const char* A; const char* B; int nM, G, c; size_t tstep, astride;
    __device__ __forceinline__ bool next(int i, Unit& u) const { const long L = (long)i * G + c; if (L >= (long)nM * 40) return false; tile_of((int)L, nM, 40, u.pm, u.pn); u.g = u.pn >> 3; return true; }
    __device__ __forceinline__ const char* a_ptr(const Unit& u) const { return A + (size_t)u.g * astride + (size_t)u.pm * tstep; }
    __device__ __forceinline__ const char* b_ptr(const Unit& u) const { return B + (size_t)u.pn * tstep; }
};
struct SchedM3 : SchedBase {
    const char* A0; const char* B0; const char* A1; const char* B1; int nM0, nN0, nM1, nN1, G, c; size_t tstep;
    __device__ __forceinline__ bool next(int i, Unit& u) const { const long L = (long)i * G + c; const int n0 = nM0 * nN0; if (L >= (long)n0 + nM1 * nN1) return false;
        if (L < n0) { tile_of((int)L, nM0, nN0, u.pm, u.pn); u.g = 0; } else { tile_of((int)L - n0, nM1, nN1, u.pm, u.pn); u.g = 1; } return true; }
    __device__ __forceinline__ const char* a_ptr(const Unit& u) const { return (u.g ? A1 : A0) + (size_t)u.pm * tstep; }
    __device__ __forceinline__ const char* b_ptr(const Unit& u) const { return (u.g ? B1 : B0) + (size_t)u.pn * tstep; }
};

__device__ __forceinline__ unsigned cvt_pk_bf16(float lo, float hi) { unsigned r; asm volatile("s_nop 0\n\tv_cvt_pk_bf16_f32 %0, %1, %2" : "=v"(r) : "v"(lo), "v"(hi)); return r; }
typedef unsigned u32x2 __attribute__((ext_vector_type(2)));
__device__ __forceinline__ float fast_sigmoid(float x) { return __builtin_amdgcn_rcpf(1.0f + __builtin_amdgcn_exp2f(-1.44269504f * x)); }
__device__ __forceinline__ float fast_tanh(float x) { return 1.0f - 2.0f * __builtin_amdgcn_rcpf(1.0f + __builtin_amdgcn_exp2f(2.88539008f * x)); }

struct EpiF32 {
    static constexpr bool PERM = false, AFTER_DRAIN = false;
    float* C; int ldc;
    __device__ __forceinline__ void operator()(const f32x4 (&acc)[2][2][4][2], const Unit& u, int wr, int wc, int fr, int fq) const {
        const int row0 = u.pm * BM + wr * 64 + fr, col0 = u.pn * BM + wc * 32 + 4 * fq;
#pragma unroll
        for (int ai = 0; ai < 2; ++ai)
#pragma unroll
            for (int m = 0; m < 4; ++m) { float* rowp = C + (size_t)(row0 + ai * HALF + m * 16) * ldc + col0;
#pragma unroll
                for (int bj = 0; bj < 2; ++bj)
#pragma unroll
                    for (int n = 0; n < 2; ++n) *(f32x4*)(rowp + bj * HALF + n * 16) = acc[ai][bj][m][n]; }
    }
};
template <int MB> struct EpiSwigluT {
    static constexpr bool PERM = true, AFTER_DRAIN = false;
    bf16_t* U;
    __device__ __forceinline__ void operator()(const f32x4 (&acc)[2][2][MB][2], const Unit& u, int wr, int wc, int fr, int fq) const {
        const int row0 = u.pm * (64 * MB) + wr * (16 * MB) + fr, col0 = u.pn * HALF + wc * 32 + 8 * fq;
#pragma unroll
        for (int ai = 0; ai < 2; ++ai)
#pragma unroll
            for (int m = 0; m < MB; ++m) { bf16_t* rowp = U + (size_t)(row0 + ai * (32 * MB) + m * 16) * 5632 + col0;
                u32x4 w;
#pragma unroll
                for (int n = 0; n < 2; ++n) { const f32x4 g = acc[ai][0][m][n], v = acc[ai][1][m][n]; f32x4 o;
#pragma unroll
                    for (int e = 0; e < 4; ++e) o[e] = g[e] * fast_sigmoid(g[e]) * v[e];
                    w[2 * n] = cvt_pk_bf16(o[0], o[1]); w[2 * n + 1] = cvt_pk_bf16(o[2], o[3]); }
                *(u32x4*)rowp = w; }
    }
};
__device__ __forceinline__ float bf_lo(unsigned w) { return __builtin_bit_cast(float, w << 16); }
__device__ __forceinline__ float bf_hi(unsigned w) { return __builtin_bit_cast(float, w & 0xffff0000u); }
template <int MB> struct EpiResidT {
    static constexpr bool PERM = true, AFTER_DRAIN = false;
    bf16_t* X; const float* mod; float sc;
    __device__ __forceinline__ void operator()(const f32x4 (&acc)[2][2][MB][2], const Unit& u, int wr, int wc, int fr, int fq) const {
        if (sc == 0.f) return;
        const int col0 = u.pn * BM + wc * 32 + 8 * fq;
#pragma unroll
        for (int ai = 0; ai < 2; ++ai) {
            u32x4 xv[MB][2]; f32x4 g0[MB][2], g1[MB][2];
#pragma unroll
            for (int m = 0; m < MB; ++m) { const int rb = u.pm * (64 * MB) + ai * (32 * MB) + wr * (16 * MB) + m * 16;
                const int grp = rb < 8192 ? 0 : 1 + ((rb - 8192) >> 10);
                const float* gp = mod + (size_t)grp * (9 * 2048) + col0;
                const bf16_t* rowp = X + (size_t)(rb + fr) * 2048 + col0;
#pragma unroll
                for (int bj = 0; bj < 2; ++bj) { xv[m][bj] = *(const u32x4*)(rowp + bj * HALF); g0[m][bj] = *(const f32x4*)(gp + bj * HALF); g1[m][bj] = *(const f32x4*)(gp + bj * HALF + 4); } }
#pragma unroll
            for (int m = 0; m < MB; ++m) { const int rb = u.pm * (64 * MB) + ai * (32 * MB) + wr * (16 * MB) + m * 16;
                bf16_t* rowp = X + (size_t)(rb + fr) * 2048 + col0;
#pragma unroll
                for (int bj = 0; bj < 2; ++bj) { const u32x4 x = xv[m][bj]; const f32x4 ga = g0[m][bj] * sc, gb = g1[m][bj] * sc;
                    const f32x4 a0 = acc[ai][bj][m][0], a1 = acc[ai][bj][m][1];
                    u32x4 w;
                    w.x = cvt_pk_bf16(bf_lo(x.x) + ga[0] * a0[0], bf_hi(x.x) + ga[1] * a0[1]); w.y = cvt_pk_bf16(bf_lo(x.y) + ga[2] * a0[2], bf_hi(x.y) + ga[3] * a0[3]);
                    w.z = cvt_pk_bf16(bf_lo(x.z) + gb[0] * a1[0], bf_hi(x.z) + gb[1] * a1[1]); w.w = cvt_pk_bf16(bf_lo(x.w) + gb[2] * a1[2], bf_hi(x.w) + gb[3] * a1[3]);
                    *(u32x4*)(rowp + bj * HALF) = w; } }
        }
    }
};
struct EpiM3 {
    static constexpr bool PERM = true, AFTER_DRAIN = false;
    bf16_t* Q; bf16_t* KV;
    __device__ __forceinline__ void operator()(const f32x4 (&acc)[2][2][4][2], const Unit& u, int wr, int wc, int fr, int fq) const {
        const int row0 = u.pm * BM + wr * 64 + fr, col0 = u.pn * BM + wc * 32 + 8 * fq;
        bf16_t* base = u.g ? KV : Q; const int ldc = u.g ? 4096 : 3072;
#pragma unroll
        for (int ai = 0; ai < 2; ++ai)
#pragma unroll
            for (int m = 0; m < 4; ++m) { bf16_t* rowp = base + (size_t)(row0 + ai * HALF + m * 16) * ldc + col0;
#pragma unroll
                for (int bj = 0; bj < 2; ++bj) { const f32x4 o0 = acc[ai][bj][m][0], o1 = acc[ai][bj][m][1];
                    u32x4 w; w.x = cvt_pk_bf16(o0[0], o0[1]); w.y = cvt_pk_bf16(o0[2], o0[3]); w.z = cvt_pk_bf16(o1[0], o1[1]); w.w = cvt_pk_bf16(o1[2], o1[3]); *(u32x4*)(rowp + bj * HALF) = w; } }
    }
};
struct EpiR2 {
    static constexpr bool PERM = true, AFTER_DRAIN = false;
    bf16_t* RKV; size_t rkv_stride; bf16_t* T1; size_t t1_stride; size_t rows_total;
    __device__ __forceinline__ void operator()(const f32x4 (&acc)[2][2][4][2], const Unit& u, int wr, int wc, int fr, int fq) const {
        const int row0 = u.pm * BM + wr * 64 + fr;
        if (u.g < 3) {
            bf16_t* base = RKV + (size_t)u.g * rkv_stride;
            const int hq = (u.pn & 7) * 4 + (wc >> 1), cin = (wc & 1) * 32 + 8 * fq;
            const unsigned voff = (unsigned)(row0 * 64 + cin);
#pragma unroll
            for (int bj = 0; bj < 2; ++bj) { bf16_t* hb = base + (size_t)(hq + bj * 2) * rows_total * 64;
#pragma unroll
                for (int ai = 0; ai < 2; ++ai)
#pragma unroll
                    for (int m = 0; m < 4; ++m) { const f32x4 o0 = acc[ai][bj][m][0], o1 = acc[ai][bj][m][1];
                        u32x4 w; w.x = cvt_pk_bf16(o0[0], o0[1]); w.y = cvt_pk_bf16(o0[2], o0[3]); w.z = cvt_pk_bf16(o1[0], o1[1]); w.w = cvt_pk_bf16(o1[2], o1[3]);
                        *(u32x4*)(hb + (voff + (unsigned)((ai * HALF + m * 16) * 64))) = w; } }
        } else {
            const int slot = u.g - 3; bf16_t* base = T1 + (size_t)slot * t1_stride + wc * 32 + 8 * fq;
            const int act = slot == 0 ? 1 : ((slot & 1) ? 2 : 0);
#pragma unroll
            for (int ai = 0; ai < 2; ++ai)
#pragma unroll
                for (int m = 0; m < 4; ++m) { bf16_t* rowp = base + (size_t)(row0 + ai * HALF + m * 16) * 256;
#pragma unroll
                    for (int bj = 0; bj < 2; ++bj) { u32x4 w;
#pragma unroll
                        for (int n = 0; n < 2; ++n) { f32x4 o = acc[ai][bj][m][n];
                            if (act == 1) { _Pragma("unroll") for (int e = 0; e < 4; ++e) o[e] = fast_sigmoid(o[e]); }
                            else if (act == 2) { _Pragma("unroll") for (int e = 0; e < 4; ++e) o[e] = fast_tanh(o[e]); }
                            w[2 * n] = cvt_pk_bf16(o[0], o[1]); w[2 * n + 1] = cvt_pk_bf16(o[2], o[3]); }
                        *(u32x4*)(rowp + bj * HALF) = w; } }
        }
    }
};
__device__ __forceinline__ unsigned cvt_pk_unorm16(float lo, float hi) { unsigned r; asm volatile("s_nop 0\n\tv_cvt_pknorm_u16_f32 %0, %1, %2" : "=v"(r) : "v"(lo), "v"(hi)); return r; }
struct EpiR3 {
    static constexpr bool PERM = true, AFTER_DRAIN = false;
    bf16_t* G; bf16_t* DEC; bf16_t* AA; size_t dstride; const float* w0; const float* a0; size_t rows_total;
    template <int KIND> __device__ __forceinline__ void run(const f32x4 (&acc)[2][2][4][2], bf16_t* base, const float* bp, int row0, int hq, int cin) const {
#pragma unroll
        for (int bj = 0; bj < 2; ++bj) { f32x4 bv0 = (f32x4){0.f, 0.f, 0.f, 0.f}, bv1 = bv0; if (KIND != 0) { bv0 = *(const f32x4*)(bp + bj * HALF); bv1 = *(const f32x4*)(bp + bj * HALF + 4); }
            bf16_t* hb = KIND == 0 ? base : base + (size_t)(hq + bj * 2) * rows_total * 64;
            const unsigned voff = KIND == 0 ? (unsigned)(row0 * 2048 + cin + bj * HALF) : (unsigned)(row0 * 64 + cin);
#pragma unroll
            for (int ai = 0; ai < 2; ++ai)
#pragma unroll
                for (int m = 0; m < 4; ++m) { f32x4 o0 = acc[ai][bj][m][0] + bv0, o1 = acc[ai][bj][m][1] + bv1; const int rr_ = ai * HALF + m * 16; u32x4 w;
                    if (KIND == 1) { _Pragma("unroll") for (int e = 0; e < 4; ++e) { o0[e] = 2.0f * __builtin_amdgcn_exp2f((-0.60653066f * 1.44269504f) * fast_sigmoid(o0[e])) - 1.0f; o1[e] = 2.0f * __builtin_amdgcn_exp2f((-0.60653066f * 1.44269504f) * fast_sigmoid(o1[e])) - 1.0f; } }
                    if (KIND == 2) { _Pragma("unroll") for (int e = 0; e < 4; ++e) { o0[e] = fast_sigmoid(o0[e]); o1[e] = fast_sigmoid(o1[e]); } }
                    if (KIND == 0) { w.x = cvt_pk_bf16(o0[0], o0[1]); w.y = cvt_pk_bf16(o0[2], o0[3]); w.z = cvt_pk_bf16(o1[0], o1[1]); w.w = cvt_pk_bf16(o1[2], o1[3]); }
                    else { w.x = cvt_pk_unorm16(o0[0], o0[1]); w.y = cvt_pk_unorm16(o0[2], o0[3]); w.z = cvt_pk_unorm16(o1[0], o1[1]); w.w = cvt_pk_unorm16(o1[2], o1[3]); }
                    *(u32x4*)(hb + (voff + (unsigned)(rr_ * (KIND == 0 ? 2048 : 64)))) = w; } }
    }
    __device__ __forceinline__ void operator()(const f32x4 (&acc)[2][2][4][2], const Unit& u, int wr, int wc, int fr, int fq) const {
        const int lane_ = lane_id_v(), fq8 = 8 * (lane_ >> 4);
        const int row0 = u.pm * BM + wr * 64 + (lane_ & 15), col0 = (u.pn & 7) * BM + wc * 32 + fq8;
        const int hq = (u.pn & 7) * 4 + (wc >> 1), cin = (wc & 1) * 32 + fq8;
        const int slot = u.g, dir = slot == 0 ? 0 : ((slot - 1) >> 1);
        if (slot == 0) run<0>(acc, G, w0, row0, hq, col0);
        else if (slot & 1) run<1>(acc, DEC + (size_t)dir * dstride, w0 + dir * 2048 + col0, row0, hq, cin);
        else run<2>(acc, AA + (size_t)dir * dstride, a0 + dir * 2048 + col0, row0, hq, cin);
    }
};
}
#define LAS __attribute__((address_space(3)))
#define XB_TMO      128
#define XB_XCNT(j)  (256  + 64 * (j))
#define XB_XSUB(j)  (1280 + 64 * (j))
#define XB_XGEN(j)  (2304 + 64 * (j))
#define XB_TOP      3328
#define XB_TOPGEN   3392
#define XCD_BAR_WORDS 3456
#define XB_SPIN_CAP (1u << 18)


__device__ __forceinline__ unsigned xb_ld(unsigned* p)              { return __hip_atomic_load(p, __ATOMIC_RELAXED, __HIP_MEMORY_SCOPE_AGENT); }
__device__ __forceinline__ unsigned xb_add(unsigned* p, unsigned v) { return __hip_atomic_fetch_add(p, v, __ATOMIC_RELAXED, __HIP_MEMORY_SCOPE_AGENT); }
__device__ __forceinline__ unsigned xb_xcc_id() { return (unsigned)__builtin_amdgcn_s_getreg((3 << 11) | 20) & 0xFu; }
#define XB_SPIN(cond, bar) do { unsigned _sp = 0; while (cond) { __builtin_amdgcn_s_sleep(1); \
    if ((++_sp & 255u) == 0u) { if (xb_ld(&(bar)[XB_TMO])) break; if (_sp > XB_SPIN_CAP) { atomicAdd(&(bar)[XB_TMO], 1u); break; } } } } while (0)

struct XcdBarrier {
    unsigned* bar; unsigned x; unsigned lead;
    volatile LAS unsigned* st;
};

__device__ __forceinline__ XcdBarrier xcd_barrier_post(unsigned* bar, volatile LAS unsigned* st) {
    XcdBarrier b; b.bar = bar; b.x = xb_xcc_id(); b.st = st; b.lead = threadIdx.x == 0 ? 1u : 0u;
    if (threadIdx.x == 0) (void)xb_add(&bar[XB_XCNT(b.x)], 1u);
    return b;
}
__device__ __forceinline__ void xcd_barrier_complete(unsigned* bar, unsigned x, unsigned& nloc, unsigned& nx) {
    const unsigned G = gridDim.x * gridDim.y * gridDim.z;
    unsigned sum, cnt, mine, sp = 0u;
    for (;;) {
        sum = 0u; cnt = 0u; mine = 0u;
#pragma unroll
        for (unsigned j = 0; j < 16; ++j) { const unsigned c = xb_ld(&bar[XB_XCNT(j)]); sum += c; cnt += (c > 0u) ? 1u : 0u; mine = (j == x) ? c : mine; }
        if (sum == G) break;
        __builtin_amdgcn_s_sleep(1);
        if ((++sp & 255u) == 0u) { if (xb_ld(&bar[XB_TMO])) break; if (sp > XB_SPIN_CAP) { atomicAdd(&bar[XB_TMO], 1u); break; } }
    }
    nloc = mine > 0u ? mine : 1u; nx = cnt > 0u ? cnt : 1u;
}

__device__ __forceinline__ void xcd_barrier(const XcdBarrier& b) {
    asm volatile("s_waitcnt vmcnt(0)" ::: "memory");
    __syncthreads();
    if (b.lead) {
        unsigned* bar = b.bar;
        __builtin_amdgcn_s_waitcnt(0);
        unsigned nloc = b.st[0], nx = b.st[1];
        if (nloc == 0u) { xcd_barrier_complete(bar, b.x, nloc, nx); b.st[0] = nloc; b.st[1] = nx; }
        const unsigned old = xb_add(&bar[XB_XSUB(b.x)], 1u);
        const unsigned gen = old / nloc;
        if (old + 1u == (gen + 1u) * nloc) {
            __builtin_amdgcn_fence(__ATOMIC_RELEASE, "agent");
            asm volatile("s_waitcnt vmcnt(0)" ::: "memory");
            const unsigned og = xb_add(&bar[XB_TOP], 1u);
            const unsigned tg = og / nx;
            if (og + 1u == (tg + 1u) * nx) xb_add(&bar[XB_TOPGEN], 1u);
            else XB_SPIN(xb_ld(&bar[XB_TOPGEN]) == tg, bar);
            __builtin_amdgcn_fence(__ATOMIC_ACQUIRE, "agent");
            xb_add(&bar[XB_XGEN(b.x)], 1u);
            asm volatile("s_waitcnt vmcnt(0)" ::: "memory");
        } else {
            XB_SPIN(xb_ld(&bar[XB_XGEN(b.x)]) == gen, bar);
            __builtin_amdgcn_fence(__ATOMIC_ACQUIRE, "agent");
            asm volatile("s_waitcnt vmcnt(0)" ::: "memory");
        }
    }
    __syncthreads();
}


constexpr int D = 2048, MP = 8192, MS = 4096, M = 12288, DFF = 5632, NFI = 11264, KVROWS = 14336;
constexpr int NWAVES = 8, NTHR = 512;
constexpr float RMS_EPS = 1e-6f, GN_EPS = 64e-5f;
constexpr size_t MiB = 1u << 20;
constexpr size_t WS_CTL = 0, CTL_ZERO_BYTES = 1 * MiB;
constexpr size_t WS_MOD = 1 * MiB;
constexpr size_t WS_X = 4 * MiB;
constexpr size_t WS_H = 100 * MiB;
constexpr size_t WS_U = 148 * MiB;
constexpr size_t WS_WFI = 280 * MiB;
constexpr size_t WS_WFO = 632 * MiB;
constexpr size_t WS_WMLA = 808 * MiB;
constexpr size_t WS_WRW = 848 * MiB;
constexpr size_t WS_ACT = 932 * MiB;
constexpr size_t A_RAW = WS_ACT, A_CQ = WS_ACT + 60 * MiB, A_CKV = WS_ACT + 72 * MiB, A_KR = WS_ACT + 86 * MiB, A_Q = WS_ACT + 88 * MiB, A_KV = WS_ACT + 160 * MiB, A_O = WS_ACT + 272 * MiB;
constexpr size_t B_XMIX = WS_ACT, B_DEC = WS_ACT, B_AA = WS_ACT + 192 * MiB, B_RKV = WS_ACT + 384 * MiB, B_G = WS_ACT + 672 * MiB, B_T1 = WS_ACT + 768 * MiB, B_Y = WS_ACT + 798 * MiB,
                 B_BON = WS_ACT + 990 * MiB, B_O2 = WS_ACT + 993 * MiB;
constexpr size_t WS_END = WS_ACT + 1041 * MiB;
constexpr size_t O_YP = 0, O_YS = 16777216, O_CKV = 25165824, O_KR = 33554432, O_SF = 34603008, O_SB = 42991616, O_END = 51380224;
constexpr int CW_BAR = 4096, CW_DBG = 64;
constexpr int LDS_BYTES = 147456, MISC_OFF = LDS_BYTES - 256;

#define GAS __attribute__((address_space(1)))
typedef unsigned short bf16;
typedef unsigned v4u __attribute__((ext_vector_type(4)));
typedef unsigned v2u __attribute__((ext_vector_type(2)));
typedef float f32x4 __attribute__((ext_vector_type(4)));
typedef float f32x2 __attribute__((ext_vector_type(2)));
typedef short bf16x8 __attribute__((ext_vector_type(8)));
typedef short s16x4 __attribute__((ext_vector_type(4)));
#define LDS_WAIT() asm volatile("s_waitcnt lgkmcnt(0)" ::: "memory")
__device__ __forceinline__ unsigned f2bf(float f) { unsigned u = __builtin_bit_cast(unsigned, f); return (u + 0x7fffu + ((u >> 16) & 1u)) >> 16; }
__device__ __forceinline__ unsigned pk2(float lo, float hi) { return pg8::cvt_pk_bf16(lo, hi); }
__device__ __forceinline__ float bflo(unsigned w) { return __builtin_bit_cast(float, w << 16); }
__device__ __forceinline__ float bfhi(unsigned w) { return __builtin_bit_cast(float, w & 0xffff0000u); }
__device__ __forceinline__ float xdpp(float v, int ctrl_b1_or_4e) { return ctrl_b1_or_4e == 1 ? __builtin_bit_cast(float, __builtin_amdgcn_update_dpp(0, __builtin_bit_cast(int, v), 0xB1, 0xF, 0xF, true))
                                                                                             : __builtin_bit_cast(float, __builtin_amdgcn_update_dpp(0, __builtin_bit_cast(int, v), 0x4E, 0xF, 0xF, true)); }
__device__ __forceinline__ float xswz4(float v) { return __builtin_bit_cast(float, __builtin_amdgcn_ds_swizzle(__builtin_bit_cast(int, v), 0x101F)); }
__device__ __forceinline__ float xswz8(float v) { return __builtin_bit_cast(float, __builtin_amdgcn_ds_swizzle(__builtin_bit_cast(int, v), 0x201F)); }
__device__ __forceinline__ float xswz16(float v) { return __builtin_bit_cast(float, __builtin_amdgcn_ds_swizzle(__builtin_bit_cast(int, v), 0x401F)); }
__device__ __forceinline__ float sum_x32(float v) { unsigned a_ = __builtin_bit_cast(unsigned, v), b_ = a_; asm volatile("" : "+v"(b_));
    auto r = __builtin_amdgcn_permlane32_swap(a_, b_, false, false); const unsigned r0 = r[0], r1 = r[1];
    return __builtin_bit_cast(float, r0) + __builtin_bit_cast(float, r1); }
__device__ __forceinline__ float max_x32(float v) { unsigned a_ = __builtin_bit_cast(unsigned, v), b_ = a_; asm volatile("" : "+v"(b_));
    auto r = __builtin_amdgcn_permlane32_swap(a_, b_, false, false); const unsigned r0 = r[0], r1 = r[1];
    return fmaxf(__builtin_bit_cast(float, r0), __builtin_bit_cast(float, r1)); }
__device__ __forceinline__ float quad_sum(float v) { v += xdpp(v, 1); v += xdpp(v, 2); return v; }
__device__ __forceinline__ float sum16(float v) { v = quad_sum(v);
    v += __builtin_bit_cast(float, __builtin_amdgcn_update_dpp(0, __builtin_bit_cast(int, v), 0x141, 0xF, 0xF, true));
    v += __builtin_bit_cast(float, __builtin_amdgcn_update_dpp(0, __builtin_bit_cast(int, v), 0x140, 0xF, 0xF, true));
    return v; }
__device__ __forceinline__ float wave_sum(float v) { v = sum16(v); v += xswz16(v); return sum_x32(v); }

struct Params { const float* in[40]; float* out; unsigned char* ws; int ph_lo, ph_hi; };
#define CAS __attribute__((address_space(4)))
struct InProxy { const CAS Params* p; __device__ __forceinline__ const float* operator[](int i) const { return p->in[i]; } };
struct PP { InProxy in; float* out; unsigned char* ws; };
__device__ __forceinline__ PP make_pp() {
    const unsigned long long a = (unsigned long long)(const CAS void*)__builtin_amdgcn_kernarg_segment_ptr(); const unsigned lo_ = (unsigned)pg8::opaque_s((int)(unsigned)a), hi_ = (unsigned)pg8::opaque_s((int)(unsigned)(a >> 32));
    const CAS Params* p = (const CAS Params*)(((unsigned long long)hi_ << 32) | lo_); PP r; r.in.p = p; r.out = p->out; r.ws = p->ws; return r; }
using pg8::opaque_v; using pg8::opaque_s;
struct Ctx {
    LAS unsigned char* lds; int tid, lane, wave, G, vcu, gw, ngw;
};

struct TJob { const float* W; bf16* WT; int K, N, ldw, Kpad, Npad, ldk, mode, row_off; };
__device__ __forceinline__ void transpose_item(const TJob& J, int item, LAS float* scr, int lane) {
    const int nblk = J.Npad >> 6, kb = item / nblk, nb = item - kb * nblk, k0 = kb << 6, n0 = nb << 6;
    const int kq = lane >> 4, nq = lane & 15, n = n0 + 4 * nq; const bool nok = n < J.N;
    f32x4 v[16];
#pragma unroll
    for (int i = 0; i < 16; ++i) { const int k = k0 + 4 * i + kq; v[i] = (f32x4){0.f, 0.f, 0.f, 0.f}; if (nok && k < J.K) v[i] = __builtin_nontemporal_load((const f32x4*)(J.W + (size_t)k * J.ldw + n)); }
#pragma unroll
    for (int i = 0; i < 16; ++i) { LAS float* s = scr + (4 * i + kq) * 65 + 4 * nq; s[0] = v[i][0]; s[1] = v[i][1]; s[2] = v[i][2]; s[3] = v[i][3];
        if ((i & 3) == 3) asm volatile("s_waitcnt lgkmcnt(4)" ::: "memory"); }
    LDS_WAIT(); asm volatile("" ::: "memory");
    int rbase;
    if (J.mode == 1) rbase = n0 < DFF ? (n0 >> 7) * 256 + (n0 & 127) : ((n0 - DFF) >> 7) * 256 + 128 + ((n0 - DFF) & 127);
    else rbase = J.row_off + n0;
    const int nn = lane >> 3, c = lane & 7;
    float t[2][8];
#pragma unroll
    for (int e = 0; e < 8; ++e) t[0][e] = (scr + (8 * c) * 65 + nn)[e * 65];
#pragma unroll
    for (int j = 0; j < 8; ++j) { const int nl = nn + 8 * j;
        if (j + 1 < 8) { const LAS float* s = scr + (8 * c) * 65 + nl + 8;
#pragma unroll
            for (int e = 0; e < 8; ++e) t[(j + 1) & 1][e] = s[e * 65];
            asm volatile("s_waitcnt lgkmcnt(8)" ::: "memory"); }
        else asm volatile("s_waitcnt lgkmcnt(0)" ::: "memory");
        v4u o; o.x = pk2(t[j & 1][0], t[j & 1][1]); o.y = pk2(t[j & 1][2], t[j & 1][3]); o.z = pk2(t[j & 1][4], t[j & 1][5]); o.w = pk2(t[j & 1][6], t[j & 1][7]);
        __builtin_nontemporal_store(o, (v4u*)(J.WT + (size_t)(rbase + nl) * J.ldk + k0 + 8 * c)); }
    LDS_WAIT(); asm volatile("" ::: "memory");
}
constexpr int IT_FI = 32 * 176, IT_FO = 88 * 32, IT_MLA = 2560, IT_RW = 5376;
constexpr int IT_TOTAL = 8 * IT_FI + 8 * IT_FO + 2 * IT_MLA + 2 * IT_RW;
__device__ __forceinline__ void make_job(const PP& P, int it, TJob& J, int& item) {
    unsigned char* ws = P.ws;
    J.mode = 0; J.row_off = 0;
    if (it < 8 * IT_FI) { const int mi = it / IT_FI; item = it - mi * IT_FI; J.W = P.in[12] + (size_t)mi * D * NFI; J.WT = (bf16*)(ws + WS_WFI) + (size_t)mi * NFI * D; J.K = D; J.N = NFI; J.ldw = NFI; J.Kpad = D; J.Npad = NFI; J.ldk = D; J.mode = 1; return; }
    it -= 8 * IT_FI;
    if (it < 8 * IT_FO) { const int mi = it / IT_FO; item = it - mi * IT_FO; J.W = P.in[13] + (size_t)mi * DFF * D; J.WT = (bf16*)(ws + WS_WFO) + (size_t)mi * D * DFF; J.K = DFF; J.N = D; J.ldw = D; J.Kpad = DFF; J.Npad = D; J.ldk = DFF; return; }
    it -= 8 * IT_FO;
    if (it < 2 * IT_MLA) { const int j = it / IT_MLA; it -= j * IT_MLA; unsigned char* wb = ws + WS_WMLA + (size_t)j * 20 * MiB;
        if (it < 256) { item = it; J.W = P.in[14] + (size_t)j * D * 512; J.WT = (bf16*)wb; J.K = D; J.N = 512; J.ldw = 512; J.Kpad = D; J.Npad = 512; J.ldk = D; return; }
        it -= 256;
        if (it < 288) { item = it; J.W = P.in[17] + (size_t)j * D * 576; J.WT = (bf16*)wb; J.K = D; J.N = 576; J.ldw = 576; J.Kpad = D; J.Npad = 576; J.ldk = D; J.row_off = 512; return; }
        it -= 288;
        if (it < 96) { item = it; J.W = P.in[17]; J.WT = (bf16*)wb; J.K = D; J.N = 0; J.ldw = 576; J.Kpad = D; J.Npad = 192; J.ldk = D; J.row_off = 1088; return; }
        it -= 96;
        if (it < 384) { item = it; J.W = P.in[16] + (size_t)j * 512 * 3072; J.WT = (bf16*)(wb + 5 * MiB); J.K = 512; J.N = 3072; J.ldw = 3072; J.Kpad = 512; J.Npad = 3072; J.ldk = 512; return; }
        it -= 384;
        if (it < 512) { item = it; J.W = P.in[19] + (size_t)j * 512 * 4096; J.WT = (bf16*)(wb + 8 * MiB); J.K = 512; J.N = 4096; J.ldw = 4096; J.Kpad = 512; J.Npad = 4096; J.ldk = 512; return; }
        it -= 512;
        item = it; J.W = P.in[20] + (size_t)j * D * D; J.WT = (bf16*)(wb + 12 * MiB); J.K = D; J.N = D; J.ldw = D; J.Kpad = D; J.Npad = D; J.ldk = D; return; }
    it -= 2 * IT_MLA;
    { const int j = it / IT_RW; it -= j * IT_RW; unsigned char* wb = ws + WS_WRW + (size_t)j * 42 * MiB;
        if (it < 3072) { const int mi = it >> 10; item = it & 1023; J.W = P.in[23 + mi] + (size_t)j * D * D; J.WT = (bf16*)wb; J.K = D; J.N = D; J.ldw = D; J.Kpad = D; J.Npad = D; J.ldk = D; J.row_off = mi * D; return; }
        it -= 3072;
        if (it < 640) { const int slot = it >> 7; item = it & 127; J.WT = (bf16*)wb; J.K = D; J.Kpad = D; J.Npad = 256; J.ldk = D; J.row_off = 6144 + slot * 256;
            if (slot == 0) { J.W = P.in[32] + (size_t)j * D * 256; J.N = 256; J.ldw = 256; }
            else { const int dir = (slot - 1) >> 1, isa = (slot - 1) & 1; J.W = P.in[isa ? 30 : 27] + (size_t)(j * 2 + dir) * D * 96; J.N = 96; J.ldw = 96; }
            return; }
        it -= 640;
        if (it < 640) { const int slot = it >> 7; item = it & 127; J.WT = (bf16*)(wb + 29 * MiB); J.Kpad = 256; J.N = D; J.ldw = D; J.Npad = D; J.ldk = 256; J.row_off = slot * D;
            if (slot == 0) { J.W = P.in[33] + (size_t)j * 256 * D; J.K = 256; }
            else { const int dir = (slot - 1) >> 1, isa = (slot - 1) & 1; J.W = P.in[isa ? 31 : 28] + (size_t)(j * 2 + dir) * 96 * D; J.K = 96; }
            return; }
        it -= 640;
        item = it; J.W = P.in[39] + (size_t)j * D * D; J.WT = (bf16*)(wb + 34 * MiB); J.K = D; J.N = D; J.ldw = D; J.Kpad = D; J.Npad = D; J.ldk = D; return; }
}
__device__ __forceinline__ void ada_strip(const PP& P, int s, int lane) {
    const int l = s / 288, col = (s - l * 288) * 64 + lane;
    const float* W = P.in[8] + (size_t)l * D * 18432 + col;
    float acc[5] = {0.f, 0.f, 0.f, 0.f, 0.f};
    for (int kc = 0; kc < D; kc += 64) {
        float sv[5];
#pragma unroll
        for (int g = 0; g < 5; ++g) { const float x = g == 0 ? P.in[7][kc + lane] : P.in[6][(g - 1) * D + kc + lane]; sv[g] = x / (1.0f + __expf(-x)); }
#pragma unroll 16
        for (int j = 0; j < 64; ++j) { const float w = __builtin_nontemporal_load(W + (size_t)(kc + j) * 18432);
#pragma unroll
            for (int g = 0; g < 5; ++g) acc[g] += __builtin_bit_cast(float, __builtin_amdgcn_readlane(__builtin_bit_cast(int, sv[g]), j)) * w; }
    }
    float* mod = (float*)(P.ws + WS_MOD);
    const float b = P.in[9][(size_t)l * 18432 + col];
#pragma unroll
    for (int g = 0; g < 5; ++g) mod[(size_t)(l * 5 + g) * 18432 + col] = acc[g] + b;
}
constexpr int IT_EARLY = 4 * IT_FI + 4 * IT_FO + IT_MLA + IT_RW, IT_LATE_A = 3 * IT_FI + 3 * IT_FO + IT_MLA + IT_RW, IT_LATE_B = IT_FI + IT_FO;
static_assert(IT_EARLY + IT_LATE_A + IT_LATE_B == IT_TOTAL, "item split");
__device__ __forceinline__ int early_item(int e) {
    if (e < 4 * IT_FI) { const int q = e / IT_FI, r = e - q * IT_FI; return (q < 3 ? q : 6) * IT_FI + r; } e -= 4 * IT_FI;
    if (e < 4 * IT_FO) { const int q = e / IT_FO, r = e - q * IT_FO; return 8 * IT_FI + (q < 3 ? q : 6) * IT_FO + r; } e -= 4 * IT_FO;
    if (e < IT_MLA) return 8 * IT_FI + 8 * IT_FO + e; e -= IT_MLA;
    return 8 * IT_FI + 8 * IT_FO + 2 * IT_MLA + e;
}
__device__ __forceinline__ int late_item(int t, int set) {
    if (set == 0) {
        if (t < 3 * IT_FI) return 3 * IT_FI + t; t -= 3 * IT_FI;
        if (t < 3 * IT_FO) return 8 * IT_FI + 3 * IT_FO + t; t -= 3 * IT_FO;
        if (t < IT_MLA) return 8 * IT_FI + 8 * IT_FO + IT_MLA + t; t -= IT_MLA;
        return 8 * IT_FI + 8 * IT_FO + 2 * IT_MLA + IT_RW + t;
    }
    if (t < IT_FI) return 7 * IT_FI + t; t -= IT_FI;
    return 8 * IT_FI + 7 * IT_FO + t;
}
__device__ __forceinline__ void p0_prologue(const PP& P, const Ctx& C) {
    LAS float* scr = (LAS float*)(C.lds + C.wave * 16640);
    for (int s = C.gw; s < 1152; s += C.ngw) ada_strip(P, s, C.lane);
    for (int e = (C.ngw - 1 - C.gw); e < IT_EARLY; e += C.ngw) { TJob J; int item; make_job(P, early_item(e), J, item); transpose_item(J, item, scr, C.lane); }
    v4u* X8 = (v4u*)(P.ws + WS_X); const f32x4* xp = (const f32x4*)P.in[0]; const f32x4* xs = (const f32x4*)P.in[1];
    const int nthr = C.G * NTHR; constexpr int NP8 = MP * D / 8, NA8 = M * D / 8;
    for (int i = C.vcu * NTHR + C.tid; i < NA8; i += nthr) { const f32x4* s = i < NP8 ? xp + 2 * (size_t)i : xs + 2 * (size_t)(i - NP8); const f32x4 a = s[0], b = s[1];
        v4u w; w.x = pk2(a[0], a[1]); w.y = pk2(a[2], a[3]); w.z = pk2(b[0], b[1]); w.w = pk2(b[2], b[3]); X8[i] = w; }
}

__device__ __forceinline__ int grp_of_row(int r) { return r < MP ? 0 : 1 + ((r - MP) >> 10); }
__device__ __forceinline__ void phase_norm(const PP& P, const Ctx& C, int l, int s) {
    const bf16* X = (const bf16*)(P.ws + WS_X); bf16* H = (bf16*)(P.ws + WS_H);
    const float* g = P.in[10] + (size_t)(l * 3 + s) * D; const float* mod = (const float*)(P.ws + WS_MOD) + (size_t)l * 5 * 18432;
    int cur = -1; f32x4 ca[8], cb[8];
    for (int r = C.gw; r < M; r += C.ngw) {
        const int grp = grp_of_row(r);
        if (grp != cur) { cur = grp; const float* sh = mod + (size_t)grp * 18432 + (3 * s) * D; const float* sc = sh + D;
#pragma unroll
            for (int j = 0; j < 8; ++j) { const int c = 8 * C.lane + 512 * (j >> 1) + 4 * (j & 1); const f32x4 gg = *(const f32x4*)(g + c), ss = *(const f32x4*)(sc + c); ca[j] = gg * (ss + 1.0f); cb[j] = *(const f32x4*)(sh + c); } }
        f32x4 v[8]; float q = 0.f;
        if (l == 0 && s == 0) {
            const float* xsrc = r < MP ? P.in[0] + (size_t)r * D : P.in[1] + (size_t)(r - MP) * D;
#pragma unroll
            for (int j = 0; j < 8; ++j) v[j] = *(const f32x4*)(xsrc + 8 * C.lane + 512 * (j >> 1) + 4 * (j & 1));
        } else {
#pragma unroll
            for (int jj = 0; jj < 4; ++jj) { const v4u w = *(const v4u*)(X + (size_t)r * D + 8 * C.lane + 512 * jj);
                v[2 * jj] = (f32x4){bflo(w.x), bfhi(w.x), bflo(w.y), bfhi(w.y)}; v[2 * jj + 1] = (f32x4){bflo(w.z), bfhi(w.z), bflo(w.w), bfhi(w.w)}; }
        }
#pragma unroll
        for (int j = 0; j < 8; ++j) q += (v[j][0] * v[j][0] + v[j][1] * v[j][1]) + (v[j][2] * v[j][2] + v[j][3] * v[j][3]);
        const float rstd = 1.0f / sqrtf(wave_sum(q) * (1.0f / D) + RMS_EPS);
#pragma unroll
        for (int jj = 0; jj < 4; ++jj) { const f32x4 y0 = v[2 * jj] * rstd * ca[2 * jj] + cb[2 * jj], y1 = v[2 * jj + 1] * rstd * ca[2 * jj + 1] + cb[2 * jj + 1];
            v4u w; w.x = pk2(y0[0], y0[1]); w.y = pk2(y0[2], y0[3]); w.z = pk2(y1[0], y1[1]); w.w = pk2(y1[2], y1[3]); *(v4u*)(H + (size_t)r * D + 8 * C.lane + 512 * jj) = w; }
    }
}
__device__ __forceinline__ void phase_final(const PP& P, const Ctx& C) {
    const bf16* X = (const bf16*)(P.ws + WS_X); const float* g = P.in[11];
    f32x4 ca[8];
#pragma unroll
    for (int j = 0; j < 8; ++j) ca[j] = *(const f32x4*)(g + 8 * C.lane + 512 * (j >> 1) + 4 * (j & 1));
    for (int r = C.gw; r < M; r += C.ngw) {
        f32x4 v[8]; float q = 0.f;
#pragma unroll
        for (int jj = 0; jj < 4; ++jj) { const v4u w = *(const v4u*)(X + (size_t)r * D + 8 * C.lane + 512 * jj);
            v[2 * jj] = (f32x4){bflo(w.x), bfhi(w.x), bflo(w.y), bfhi(w.y)}; v[2 * jj + 1] = (f32x4){bflo(w.z), bfhi(w.z), bflo(w.w), bfhi(w.w)}; }
#pragma unroll
        for (int j = 0; j < 8; ++j) q += (v[j][0] * v[j][0] + v[j][1] * v[j][1]) + (v[j][2] * v[j][2] + v[j][3] * v[j][3]);
        const float rstd = 1.0f / sqrtf(wave_sum(q) * (1.0f / D) + RMS_EPS);
        float* o = P.out + O_YP + (size_t)r * D + 8 * C.lane;
#pragma unroll
        for (int j = 0; j < 8; ++j) *(f32x4*)(o + 512 * (j >> 1) + 4 * (j & 1)) = v[j] * rstd * ca[j];
    }
}

__device__ __forceinline__ float rope_inv(int f) { return __expf(-(float)f * (9.210340372f / 16.0f)); }
__device__ __forceinline__ float rope_lane(float x, int lane, int t) {
    const float xp = xswz16(x);
    const int axis = lane >> 5, half = (lane >> 4) & 1, f = lane & 15;
    const float pos = (float)(axis == 0 ? (t >> 6) : (t & 63)); const float ang = pos * rope_inv(f);
    float sn, cs; sincosf(ang, &sn, &cs);
    return half == 0 ? x * cs - xp * sn : x * cs + xp * sn;
}
__device__ __forceinline__ void phase_mla_norm(const PP& P, const Ctx& C, int j) {
    const float* RAW = (const float*)(P.ws + A_RAW); bf16* CQ = (bf16*)(P.ws + A_CQ); bf16* CKV = (bf16*)(P.ws + A_CKV); bf16* KR = (bf16*)(P.ws + A_KR);
    const float* qn = P.in[15] + j * 512; const float* kn = P.in[18] + j * 512;
    f32x4 gq[2], gk[2];
#pragma unroll
    for (int jj = 0; jj < 2; ++jj) { gq[jj] = *(const f32x4*)(qn + 4 * C.lane + 256 * jj); gk[jj] = *(const f32x4*)(kn + 4 * C.lane + 256 * jj); }
    for (int r = C.gw; r < M + 2048; r += C.ngw) {
        if (r < M) {
            const float* rw = RAW + (size_t)r * 1280;
            f32x4 a[2], b[2]; float qa = 0.f, qb = 0.f;
#pragma unroll
            for (int jj = 0; jj < 2; ++jj) { a[jj] = *(const f32x4*)(rw + 4 * C.lane + 256 * jj); b[jj] = *(const f32x4*)(rw + 512 + 4 * C.lane + 256 * jj);
                qa += (a[jj][0] * a[jj][0] + a[jj][1] * a[jj][1]) + (a[jj][2] * a[jj][2] + a[jj][3] * a[jj][3]); qb += (b[jj][0] * b[jj][0] + b[jj][1] * b[jj][1]) + (b[jj][2] * b[jj][2] + b[jj][3] * b[jj][3]); }
            const float kr = rw[1024 + C.lane];
            const float ra = 1.0f / sqrtf(wave_sum(qa) * (1.0f / 512) + RMS_EPS), rb = 1.0f / sqrtf(wave_sum(qb) * (1.0f / 512) + RMS_EPS);
            int kvrow; float krv = kr;
            if (r < MP) { kvrow = r; const int b_ = r >> 8, t = r & 255;
                float* oc = P.out + O_CKV + ((size_t)(b_ * 2 + j) * 256 + t) * 512;
#pragma unroll
                for (int jj = 0; jj < 2; ++jj) *(f32x4*)(oc + 4 * C.lane + 256 * jj) = b[jj] * rb * gk[jj];
                P.out[O_KR + ((size_t)(b_ * 2 + j) * 256 + t) * 64 + C.lane] = kr;
            } else { const int lb = (r - MP) >> 10, t = (r - MP) & 1023; kvrow = MP + lb * 1536 + 512 + t; krv = rope_lane(kr, C.lane, t); }
#pragma unroll
            for (int jj = 0; jj < 2; ++jj) { const f32x4 y = a[jj] * ra * gq[jj]; v2u w; w.x = pk2(y[0], y[1]); w.y = pk2(y[2], y[3]); *(v2u*)(CQ + (size_t)r * 512 + 4 * C.lane + 256 * jj) = w;
                const f32x4 z = b[jj] * rb * gk[jj]; v2u w2; w2.x = pk2(z[0], z[1]); w2.y = pk2(z[2], z[3]); *(v2u*)(CKV + (size_t)kvrow * 512 + 4 * C.lane + 256 * jj) = w2; }
            KR[(size_t)kvrow * 64 + C.lane] = (bf16)f2bf(krv);
        } else {
            const int q = r - M, lb = q >> 9, s = q & 511, kvrow = MP + lb * 1536 + s;
            const float* cc = P.in[2] + ((size_t)(lb * 2 + j) * 512 + s) * 512;
#pragma unroll
            for (int jj = 0; jj < 2; ++jj) { const f32x4 z = *(const f32x4*)(cc + 4 * C.lane + 256 * jj); v2u w2; w2.x = pk2(z[0], z[1]); w2.y = pk2(z[2], z[3]); *(v2u*)(CKV + (size_t)kvrow * 512 + 4 * C.lane + 256 * jj) = w2; }
            KR[(size_t)kvrow * 64 + C.lane] = (bf16)f2bf(P.in[3][((size_t)(lb * 2 + j) * 512 + s) * 64 + C.lane]);
        }
    }
}
__device__ __forceinline__ void phase_q_rope(const PP& P, const Ctx& C) {
    bf16* Q = (bf16*)(P.ws + A_Q);
    for (int it = C.gw; it < MS * 16; it += C.ngw) { const int rr = it >> 4, h = it & 15, t = rr & 1023;
        bf16* p = Q + (size_t)(MP + rr) * 3072 + h * 192 + 128 + C.lane;
        const float x = __builtin_bit_cast(float, (unsigned)(*p) << 16);
        *p = (bf16)f2bf(rope_lane(x, C.lane, t)); }
}

constexpr int AT_KSTR = 400, AT_VSTR = 288, AT_KBUF = 64 * AT_KSTR, AT_VBUF = 64 * AT_VSTR, AT_BUF = AT_KBUF + AT_VBUF;
__device__ __forceinline__ void attn_unit(const Ctx& C, const bf16* Q, const bf16* KV, const bf16* KR, bf16* O, int qrow0, int krow0, int T, int h, bool rope) {
    const int tid = C.tid, lane = C.lane, wave = C.wave, fr = lane & 15, fq = lane >> 4;
    LAS unsigned char* lds = C.lds;
    bf16x8 qf[2][6];
#pragma unroll
    for (int qb = 0; qb < 2; ++qb)
#pragma unroll
        for (int ks = 0; ks < 6; ++ks) qf[qb][ks] = *(const bf16x8*)(Q + (size_t)(qrow0 + wave * 32 + qb * 16 + fr) * 3072 + h * 192 + ks * 32 + fq * 8);
    if (rope) {
        const int half = fq >> 1, f0 = (fq & 1) * 8, paddr = (lane ^ 32) << 2;
#pragma unroll
        for (int qb = 0; qb < 2; ++qb) { const int t = (qrow0 + wave * 32 + qb * 16 + fr - MP) & 1023;
#pragma unroll
            for (int ax = 0; ax < 2; ++ax) { const float pos = (float)(ax == 0 ? (t >> 6) : (t & 63));
                const v4u own = __builtin_bit_cast(v4u, qf[qb][4 + ax]); v4u par, outw;
#pragma unroll
                for (int d = 0; d < 4; ++d) par[d] = (unsigned)__builtin_amdgcn_ds_bpermute(paddr, (int)own[d]);
#pragma unroll
                for (int d = 0; d < 4; ++d) { float o2[2];
#pragma unroll
                    for (int e = 0; e < 2; ++e) { const int f = f0 + 2 * d + e; const float rev = pos * rope_inv(f) * 0.15915494309189535f; const float sn = __builtin_amdgcn_sinf(rev), cs = __builtin_amdgcn_cosf(rev);
                        const float x = e ? bfhi(own[d]) : bflo(own[d]), xp = e ? bfhi(par[d]) : bflo(par[d]);
                        o2[e] = half == 0 ? x * cs - xp * sn : x * cs + xp * sn; }
                    outw[d] = pk2(o2[0], o2[1]); }
                qf[qb][4 + ax] = __builtin_bit_cast(bf16x8, outw); } }
    }
    f32x4 ot[2][8];
#pragma unroll
    for (int qb = 0; qb < 2; ++qb)
#pragma unroll
        for (int db = 0; db < 8; ++db) ot[qb][db] = (f32x4){0.f, 0.f, 0.f, 0.f};
    float mrun[2] = {-1e30f, -1e30f}, lrun[2] = {0.f, 0.f};
    const int nt = T >> 6;
    v4u st[5];
    const int key01 = tid >> 4, ch01 = tid & 15, key4 = tid >> 3, ch4 = tid & 7;
#define AT_LOAD(t) do { const size_t kr0 = (size_t)krow0 + (size_t)(t) * 64; \
        st[0] = *(const v4u*)(KV + (kr0 + key01) * 4096 + h * 256 + ch01 * 8); st[1] = *(const v4u*)(KV + (kr0 + 32 + key01) * 4096 + h * 256 + ch01 * 8); \
        st[2] = *(const v4u*)(KV + (kr0 + key01) * 4096 + h * 256 + 128 + ch01 * 8); st[3] = *(const v4u*)(KV + (kr0 + 32 + key01) * 4096 + h * 256 + 128 + ch01 * 8); \
        st[4] = *(const v4u*)(KR + (kr0 + key4) * 64 + ch4 * 8); } while (0)
#define AT_WRITE(b) do { LAS unsigned char* kb_ = lds + (b) * AT_BUF; LAS unsigned char* vb_ = kb_ + AT_KBUF; \
        *(LAS v4u*)(kb_ + key01 * AT_KSTR + ch01 * 16) = st[0]; *(LAS v4u*)(kb_ + (32 + key01) * AT_KSTR + ch01 * 16) = st[1]; \
        *(LAS v4u*)(vb_ + key01 * AT_VSTR + ch01 * 16) = st[2]; *(LAS v4u*)(vb_ + (32 + key01) * AT_VSTR + ch01 * 16) = st[3]; \
        *(LAS v4u*)(kb_ + key4 * AT_KSTR + 256 + ch4 * 16) = st[4]; } while (0)
    AT_LOAD(0); AT_WRITE(0);
    __syncthreads();
    const float sc2 = 0.07216878364870322f * 1.44269504088896f;
    for (int t = 0; t < nt; ++t) {
        if (t + 1 < nt) AT_LOAD(t + 1);
        LAS unsigned char* kb = lds + (t & 1) * AT_BUF; LAS unsigned char* vb = kb + AT_KBUF;
        f32x4 sacc[2][4];
#pragma unroll
        for (int qb = 0; qb < 2; ++qb)
#pragma unroll
            for (int kk = 0; kk < 4; ++kk) sacc[qb][kk] = (f32x4){0.f, 0.f, 0.f, 0.f};
#pragma unroll
        for (int ks = 0; ks < 6; ++ks)
#pragma unroll
            for (int kk = 0; kk < 4; ++kk) { const bf16x8 kf = *(const LAS bf16x8*)(kb + (kk * 16 + fr) * AT_KSTR + ks * 64 + fq * 16);
#pragma unroll
                for (int qb = 0; qb < 2; ++qb) sacc[qb][kk] = __builtin_amdgcn_mfma_f32_16x16x32_bf16(kf, qf[qb][ks], sacc[qb][kk], 0, 0, 0); }
        bf16x8 pf[2][2];
#pragma unroll
        for (int qb = 0; qb < 2; ++qb) {
            float mx = -1e30f;
#pragma unroll
            for (int kk = 0; kk < 4; ++kk)
#pragma unroll
                for (int e = 0; e < 4; ++e) { sacc[qb][kk][e] *= sc2; mx = fmaxf(mx, sacc[qb][kk][e]); }
            mx = fmaxf(mx, xswz16(mx)); mx = max_x32(mx);
            const float mnew = fmaxf(mrun[qb], mx), alpha = __builtin_amdgcn_exp2f(mrun[qb] - mnew);
            mrun[qb] = mnew;
            float ps = 0.f;
#pragma unroll
            for (int kk = 0; kk < 4; ++kk)
#pragma unroll
                for (int e = 0; e < 4; ++e) { const float p = __builtin_amdgcn_exp2f(sacc[qb][kk][e] - mnew); sacc[qb][kk][e] = p; ps += p; }
            lrun[qb] = lrun[qb] * alpha + ps;
#pragma unroll
            for (int db = 0; db < 8; ++db) ot[qb][db] = ot[qb][db] * alpha;
#pragma unroll
            for (int k2 = 0; k2 < 2; ++k2) { v4u w; w.x = pk2(sacc[qb][2 * k2][0], sacc[qb][2 * k2][1]); w.y = pk2(sacc[qb][2 * k2][2], sacc[qb][2 * k2][3]);
                w.z = pk2(sacc[qb][2 * k2 + 1][0], sacc[qb][2 * k2 + 1][1]); w.w = pk2(sacc[qb][2 * k2 + 1][2], sacc[qb][2 * k2 + 1][3]); pf[qb][k2] = __builtin_bit_cast(bf16x8, w); }
        }
#pragma unroll
        for (int db = 0; db < 8; ++db)
#pragma unroll
            for (int k2 = 0; k2 < 2; ++k2) {
                const s16x4 lo = __builtin_amdgcn_ds_read_tr16_b64_v4i16((LAS s16x4*)(vb + (k2 * 32 + fq * 4 + (fr >> 2)) * AT_VSTR + db * 32 + 8 * (fr & 3)));
                const s16x4 hi = __builtin_amdgcn_ds_read_tr16_b64_v4i16((LAS s16x4*)(vb + (k2 * 32 + 16 + fq * 4 + (fr >> 2)) * AT_VSTR + db * 32 + 8 * (fr & 3)));
                const bf16x8 vf = __builtin_shufflevector(lo, hi, 0, 1, 2, 3, 4, 5, 6, 7);
#pragma unroll
                for (int qb = 0; qb < 2; ++qb) ot[qb][db] = __builtin_amdgcn_mfma_f32_16x16x32_bf16(vf, pf[qb][k2], ot[qb][db], 0, 0, 0);
            }
        if (t + 1 < nt) AT_WRITE((t + 1) & 1);
        __syncthreads();
    }
#undef AT_LOAD
#undef AT_WRITE
#pragma unroll
    for (int qb = 0; qb < 2; ++qb) {
        float l = lrun[qb]; l += xswz16(l); l = sum_x32(l);
        const float inv = 1.0f / l;
        bf16* op = O + (size_t)(qrow0 + wave * 32 + qb * 16 + fr) * 2048 + h * 128 + fq * 4;
#pragma unroll
        for (int db = 0; db < 8; ++db) { const f32x4 o = ot[qb][db] * inv; v2u w; w.x = pk2(o[0], o[1]); w.y = pk2(o[2], o[3]); *(v2u*)(op + db * 16) = w; }
    }
}
__device__ __forceinline__ void phase_attn(const PP& P, const Ctx& C) {
    const bf16* Q = (const bf16*)(P.ws + A_Q); const bf16* KV = (const bf16*)(P.ws + A_KV); const bf16* KR = (const bf16*)(P.ws + A_KR); bf16* O = (bf16*)(P.ws + A_O);
    for (int vc = C.vcu; vc < 256; vc += C.G) {
#pragma unroll 1
        for (int k = 0; k < 3; ++k) {
            int qrow0, krow0, T, h;
            if (k == 0) { const int lb = vc >> 6, qblk = vc & 3; h = (vc >> 2) & 15; qrow0 = MP + lb * 1024 + qblk * 256; krow0 = MP + lb * 1536; T = 1536; }
            else { const int u = vc + 256 * (k - 1), b = u >> 4; h = u & 15; qrow0 = b * 256; krow0 = b * 256; T = 256; }
            attn_unit(C, Q, KV, KR, O, qrow0, krow0, T, h, k == 0);
        }
    }
}

__device__ __forceinline__ void phase_shift(const PP& P, const Ctx& C, int j) {
    const bf16* H = (const bf16*)(P.ws + WS_H); bf16* XM = (bf16*)(P.ws + B_XMIX);
    const float* mu = P.in[21] + (size_t)j * 4 * D; const float* mud = P.in[22] + (size_t)j * 4 * D;
    for (int it = C.gw; it < 2048; it += C.ngw) {
        const int cs = it & 3, r0 = (it >> 2) * 24, c = cs * 512 + 8 * C.lane;
        f32x4 m0[8], m1[8];
#pragma unroll
        for (int i = 0; i < 8; ++i) { const float* mp = (i < 4 ? mu + i * D : mud + (i - 4) * D) + c; m0[i] = *(const f32x4*)mp; m1[i] = *(const f32x4*)(mp + 4); }
        const v4u zero4 = (v4u){0u, 0u, 0u, 0u};
        v4u hrow[26];
#pragma unroll
        for (int i = 0; i < 26; ++i) { const int r = r0 - 1 + i; hrow[i] = (r >= 0 && r < M) ? *(const v4u*)(H + (size_t)r * D + c) : zero4; }
#pragma unroll
        for (int i = 0; i < 24; ++i) { const int r = r0 + i;
            const bool isfirst = r < MP ? ((r & 255) == 0) : (((r - MP) & 1023) == 0), islast = r < MP ? ((r & 255) == 255) : (((r - MP) & 1023) == 1023);
            const v4u hc = hrow[i + 1];
            const v4u hpu = isfirst ? zero4 : hrow[i], hnu = islast ? zero4 : hrow[i + 2];
            float hv[8], xx[8];
#pragma unroll
            for (int e = 0; e < 4; ++e) { hv[2 * e] = bflo(hc[e]); hv[2 * e + 1] = bfhi(hc[e]);
                xx[2 * e] = 0.5f * (bflo(hpu[e]) + bflo(hnu[e])) - hv[2 * e]; xx[2 * e + 1] = 0.5f * (bfhi(hpu[e]) + bfhi(hnu[e])) - hv[2 * e + 1]; }
#pragma unroll
            for (int k = 0; k < 8; ++k) {
                v4u o; o.x = pk2(hv[0] + xx[0] * m0[k][0], hv[1] + xx[1] * m0[k][1]); o.y = pk2(hv[2] + xx[2] * m0[k][2], hv[3] + xx[3] * m0[k][3]);
                o.z = pk2(hv[4] + xx[4] * m1[k][0], hv[5] + xx[5] * m1[k][1]); o.w = pk2(hv[6] + xx[6] * m1[k][2], hv[7] + xx[7] * m1[k][3]);
                __builtin_nontemporal_store(o, (v4u*)(XM + (size_t)k * M * D + (size_t)r * D + c)); }
        }
    }
}

constexpr int SC_STEP = 1536, SC_TC = 4, SC_BUF = SC_TC * SC_STEP, SC_WAVE_LDS = 8192;
template <int R>
__device__ __forceinline__ void scan_chain(const PP& P, const Ctx& C, int j, int row0, int T, int head, int dir, int lat, int seq, int rowbase, bool write_bon) {
    const bf16* Rb = (const bf16*)(P.ws + B_RKV); const bf16* Kb = Rb + (size_t)M * D; const bf16* Vb = Kb + (size_t)M * D;
    const bf16* DEC = (const bf16*)(P.ws + B_DEC) + (size_t)dir * M * D; const bf16* AA = (const bf16*)(P.ws + B_AA) + (size_t)dir * M * D;
    bf16* Y = (bf16*)(P.ws + B_Y) + (size_t)dir * M * D;   float* BON = (float*)(P.ws + B_BON) + (size_t)dir * M * 32;
    const int lane = C.lane, sts = lane >> 4, sq = lane & 15, rg = lane >> 2, jq = lane & 3, irow = rowbase + R * rg;
    LAS unsigned char* buf = C.lds + C.wave * SC_WAVE_LDS;
    const int ch_off = head * 64 + 4 * sq;
    const f32x4 pkk = *(const f32x4*)(P.in[34] + (size_t)j * D + ch_off), pka = *(const f32x4*)(P.in[35] + (size_t)j * D + ch_off), prk = *(const f32x4*)(P.in[36] + (size_t)j * D + ch_off);
    f32x2 s[R][8];
    if (lat) {
#pragma unroll
        for (int rr = 0; rr < R; ++rr) { const float* s0 = (dir ? P.in[5] : P.in[4]) + ((((size_t)seq * 2 + j) * 32 + head) * 64 + irow + rr) * 64 + jq * 16;
#pragma unroll
            for (int e = 0; e < 4; ++e) { const f32x4 x = *(const f32x4*)(s0 + 4 * e); s[rr][2 * e] = (f32x2){x[0], x[1]}; s[rr][2 * e + 1] = (f32x2){x[2], x[3]}; } }
    } else {
#pragma unroll
        for (int rr = 0; rr < R; ++rr)
#pragma unroll
            for (int e = 0; e < 8; ++e) s[rr][e] = (f32x2){0.f, 0.f};
    }
    struct StageRegs { v2u r, k, v, w, a; size_t row; };
    StageRegs gA, gB;
    const int nch = T / SC_TC;
#define SC_LOAD(g, cc) do { const int t_ = dir == 0 ? SC_TC * (cc) + sts : T - SC_TC * ((cc) + 1) + sts; g.row = (size_t)(row0 + t_); const size_t off_ = ((size_t)head * M + g.row) * 64 + 4 * sq; \
        g.r = *(const v2u*)(Rb + off_); g.k = *(const v2u*)(Kb + off_); g.v = *(const v2u*)(Vb + off_); g.w = *(const v2u*)(DEC + off_); g.a = *(const v2u*)(AA + off_); } while (0)
#define SC_WRITE(g) do { const f32x4 fa_ = (f32x4){(float)(g.a.x & 0xffffu), (float)(g.a.x >> 16), (float)(g.a.y & 0xffffu), (float)(g.a.y >> 16)} * (1.0f / 65535.0f), fw_ = (f32x4){(float)(g.w.x & 0xffffu), (float)(g.w.x >> 16), (float)(g.w.y & 0xffffu), (float)(g.w.y >> 16)} * (0.5f / 65535.0f) + 0.5f; const f32x4 fr_ = (f32x4){bflo(g.r.x), bfhi(g.r.x), bflo(g.r.y), bfhi(g.r.y)}, fk_ = (f32x4){bflo(g.k.x), bfhi(g.k.x), bflo(g.k.y), bfhi(g.k.y)}, fv_ = (f32x4){bflo(g.v.x), bfhi(g.v.x), bflo(g.v.y), bfhi(g.v.y)}; const f32x4 kk = fk_ * pkk; float ss = (kk[0] * kk[0] + kk[1] * kk[1]) + (kk[2] * kk[2] + kk[3] * kk[3]); ss = sum16(ss); \
        const float inv = __builtin_amdgcn_rsqf(fmaxf(ss, 1e-24f)); const f32x4 kn = kk * inv; const f32x4 kd = fk_ * ((fa_ - 1.0f) * pka + 1.0f); \
        const f32x4 rb3 = fr_ * kd * prk; float bs = (rb3[0] + rb3[1]) + (rb3[2] + rb3[3]); bs = sum16(bs); \
        if (write_bon && sq == 0) BON[g.row * 32 + head] = bs; \
        LAS float* d_ = (LAS float*)(buf + sts * SC_STEP) + 4 * sq; \
        *(LAS f32x4*)(d_) = -kn; *(LAS f32x4*)(d_ + 64) = fw_; *(LAS f32x4*)(d_ + 128) = kn * fa_; *(LAS f32x4*)(d_ + 192) = kd; *(LAS f32x4*)(d_ + 256) = fr_; *(LAS f32x4*)(d_ + 320) = fv_; } while (0)
    bf16* yb = Y + (size_t)head * M * 64 + irow;
    auto compute_chunk = [&](int cc) __attribute__((always_inline)) {
        const int tbase = dir == 0 ? SC_TC * cc : T - SC_TC * (cc + 1);
        f32x4 xan[4];
        asm volatile("s_waitcnt lgkmcnt(2)" ::: "memory");
        { const LAS float* vp0 = (const LAS float*)(buf + (dir == 0 ? 0 : SC_TC - 1) * SC_STEP) + jq * 16;
#pragma unroll
          for (int e = 0; e < 4; ++e) xan[e] = *(const LAS f32x4*)(vp0 + 4 * e); }
#pragma unroll 2
        for (int st = 0; st < SC_TC; ++st) {
            const int ts = dir == 0 ? st : SC_TC - 1 - st;
            const LAS float* vp = (const LAS float*)(buf + ts * SC_STEP) + jq * 16;
            f32x2 a[8], w[8], b[8], k[8], r[8];
#pragma unroll
            for (int e = 0; e < 4; ++e) { a[2 * e] = (f32x2){xan[e][0], xan[e][1]}; a[2 * e + 1] = (f32x2){xan[e][2], xan[e][3]}; }
#pragma unroll
            for (int e = 0; e < 4; ++e) { const f32x4 xw = *(const LAS f32x4*)(vp + 64 + 4 * e), xb = *(const LAS f32x4*)(vp + 128 + 4 * e);
                w[2 * e] = (f32x2){xw[0], xw[1]}; w[2 * e + 1] = (f32x2){xw[2], xw[3]}; b[2 * e] = (f32x2){xb[0], xb[1]}; b[2 * e + 1] = (f32x2){xb[2], xb[3]}; }
            float vi[R];
            { const LAS float* vv = (const LAS float*)(buf + ts * SC_STEP) + 320 + irow;
              if (R == 4) { const f32x4 x = *(const LAS f32x4*)vv; vi[0] = x[0]; vi[1] = x[1]; vi[R - 2] = x[2]; vi[R - 1] = x[3]; }
              else { const f32x2 x = *(const LAS f32x2*)vv; vi[0] = x[0]; vi[1] = x[1]; } }
            float sa_[R];
#pragma unroll
            for (int rr = 0; rr < R; ++rr) {
                f32x2 sa2 = s[rr][0] * a[0], sa3 = s[rr][1] * a[1];
#pragma unroll
                for (int e = 2; e < 8; e += 2) { sa2 = s[rr][e] * a[e] + sa2; sa3 = s[rr][e + 1] * a[e + 1] + sa3; }
                sa2 = sa2 + sa3;
                sa_[rr] = quad_sum(sa2[0] + sa2[1]);
            }
            if (R == 4) asm volatile("s_waitcnt lgkmcnt(2)" : "+v"(sa_[0]), "+v"(sa_[1]), "+v"(sa_[R - 2]), "+v"(sa_[R - 1]) :: "memory");
            else asm volatile("s_waitcnt lgkmcnt(2)" : "+v"(sa_[0]), "+v"(sa_[1]) :: "memory");
#pragma unroll
            for (int e = 0; e < 4; ++e) { const f32x4 xk = *(const LAS f32x4*)(vp + 192 + 4 * e), xr = *(const LAS f32x4*)(vp + 256 + 4 * e);
                k[2 * e] = (f32x2){xk[0], xk[1]}; k[2 * e + 1] = (f32x2){xk[2], xk[3]}; r[2 * e] = (f32x2){xr[0], xr[1]}; r[2 * e + 1] = (f32x2){xr[2], xr[3]}; }
            if (st + 1 < SC_TC) { const LAS float* vpn = (const LAS float*)(buf + (dir == 0 ? st + 1 : SC_TC - 2 - st) * SC_STEP) + jq * 16;
#pragma unroll
                for (int e = 0; e < 4; ++e) xan[e] = *(const LAS f32x4*)(vpn + 4 * e); }
            float yo[R];
#pragma unroll
            for (int rr = 0; rr < R; ++rr) {
                const f32x2 sav = (f32x2){sa_[rr], sa_[rr]};
#pragma unroll
                for (int e = 0; e < 8; ++e) s[rr][e] = s[rr][e] * w[e] + b[e] * sav;
            }
#pragma unroll
            for (int rr = 0; rr < R; ++rr) {
                const f32x2 vv2 = (f32x2){vi[rr], vi[rr]};
                f32x2 y2 = (f32x2){0.f, 0.f}, y3 = (f32x2){0.f, 0.f};
#pragma unroll
                for (int e = 0; e < 8; e += 2) { s[rr][e] = k[e] * vv2 + s[rr][e]; s[rr][e + 1] = k[e + 1] * vv2 + s[rr][e + 1];
                    y2 = s[rr][e] * r[e] + y2; y3 = s[rr][e + 1] * r[e + 1] + y3; }
                y2 = y2 + y3;
                yo[rr] = quad_sum(y2[0] + y2[1]);
            }
            if (jq == 0) { bf16* yp = yb + (size_t)(row0 + tbase + ts) * 64;
                if (R == 4) { v2u w; w.x = pg8::cvt_pk_bf16(yo[0], yo[1]); w.y = pg8::cvt_pk_bf16(yo[R - 2], yo[R - 1]); *(v2u*)yp = w; } else *(unsigned*)yp = pg8::cvt_pk_bf16(yo[0], yo[1]); }
        }
    };
    SC_LOAD(gA, 0); SC_WRITE(gA);
    SC_LOAD(gA, 1);
#pragma unroll 1
    for (int cc = 0; cc < nch; cc += 2) {
        if (cc + 2 < nch) SC_LOAD(gB, cc + 2);
        compute_chunk(cc);
        SC_WRITE(gA);
        if (cc + 3 < nch) SC_LOAD(gA, cc + 3);
        compute_chunk(cc + 1);
        if (cc + 2 < nch) SC_WRITE(gB);
    }
#undef SC_LOAD
#undef SC_WRITE
    if (!lat) {
#pragma unroll
        for (int rr = 0; rr < R; ++rr) { float* so = P.out + (dir ? O_SB : O_SF) + ((((size_t)seq * 2 + j) * 32 + head) * 64 + irow + rr) * 64 + jq * 16;
#pragma unroll
            for (int e = 0; e < 4; ++e) *(f32x4*)(so + 4 * e) = (f32x4){s[rr][2 * e][0], s[rr][2 * e][1], s[rr][2 * e + 1][0], s[rr][2 * e + 1][1]}; }
    }
}
__device__ __forceinline__ void phase_scan(const PP& P, const Ctx& C, int j, int late_set) {
    for (int vc = C.vcu; vc < 256; vc += C.G) {
        if (C.wave < 2) {
            __builtin_amdgcn_s_setprio(2);
            scan_chain<2>(P, C, j, MP + (vc >> 6) * 1024, 1024, (vc >> 1) & 31, vc & 1, 1, vc >> 6, 32 * C.wave, C.wave == 0);
            __builtin_amdgcn_s_setprio(0);
        } else {
            const int m0 = C.wave < 4 ? 2 * (C.wave - 2) : C.wave, nm = C.wave < 4 ? 2 : 1;
#pragma unroll 1
            for (int q = 0; q < nm; ++q) { const int cidx = 8 * vc + m0 + q; scan_chain<4>(P, C, j, (cidx >> 6) * 256, 256, (cidx >> 1) & 31, cidx & 1, 0, cidx >> 6, 0, true); }
        }
    }
    if (late_set >= 0 && C.wave >= 4) {
        LAS float* scr = (LAS float*)(C.lds + 65536 + (C.wave - 4) * 16640);
        const int nlw = C.G * 4;
        const int nlate = late_set == 0 ? IT_LATE_A : IT_LATE_B;
        for (int t = C.vcu * 4 + (C.wave - 4); t < nlate; t += nlw) { TJob J; int item; make_job(P, late_item(t, late_set), J, item); transpose_item(J, item, scr, C.lane); }
    }
}
__device__ __forceinline__ void phase_post(const PP& P, const Ctx& C, int j) {
    const bf16* Y = (const bf16*)(P.ws + B_Y); const float* BON = (const float*)(P.ws + B_BON); const bf16* Vb = (const bf16*)(P.ws + B_RKV) + (size_t)2 * M * D; const bf16* G = (const bf16*)(P.ws + B_G);
    bf16* O2 = (bf16*)(P.ws + B_O2);
    const float* lnw = P.in[37] + (size_t)j * D; const float* lnb = P.in[38] + (size_t)j * D;
    const int hs = C.lane >> 4, q = C.lane & 15;
    for (int r = C.gw; r < M; r += C.ngw) {
        f32x4 yf[8], yb[8], vv[8], gg[8]; float b0[8], b1[8];
#pragma unroll
        for (int p = 0; p < 8; ++p) { const int head = p * 4 + hs; const size_t off = (size_t)r * D + head * 64 + 4 * q;
            const size_t hoff = ((size_t)head * M + r) * 64 + 4 * q;
            { const v2u a_ = *(const v2u*)(Y + hoff), b_ = *(const v2u*)(Y + (size_t)M * D + hoff); yf[p] = (f32x4){bflo(a_.x), bfhi(a_.x), bflo(a_.y), bfhi(a_.y)}; yb[p] = (f32x4){bflo(b_.x), bfhi(b_.x), bflo(b_.y), bfhi(b_.y)}; } { const v2u v_ = *(const v2u*)(Vb + hoff); vv[p] = (f32x4){bflo(v_.x), bfhi(v_.x), bflo(v_.y), bfhi(v_.y)}; } { const v2u gw_ = *(const v2u*)(G + off); gg[p] = (f32x4){bflo(gw_.x), bfhi(gw_.x), bflo(gw_.y), bfhi(gw_.y)}; }
            b0[p] = BON[(size_t)r * 32 + head]; b1[p] = BON[((size_t)M + r) * 32 + head]; }
#pragma unroll
        for (int p = 0; p < 8; ++p) { const int head = p * 4 + hs, c = head * 64 + 4 * q; const size_t off = (size_t)r * D + c;
            const f32x4 y = yf[p] + yb[p];
            const float mean = sum16((y[0] + y[1]) + (y[2] + y[3])) * (1.0f / 64);
            const f32x4 d = y - mean;
            const float var = sum16((d[0] * d[0] + d[1] * d[1]) + (d[2] * d[2] + d[3] * d[3])) * (1.0f / 64);
            const float rs = __builtin_amdgcn_rsqf(var + GN_EPS);
            const f32x4 o = (d * rs * *(const f32x4*)(lnw + c) + *(const f32x4*)(lnb + c) + vv[p] * (b0[p] + b1[p])) * gg[p];
            v2u w; w.x = pk2(o[0], o[1]); w.y = pk2(o[2], o[3]); *(v2u*)(O2 + off) = w; }
    }
}

__device__ __forceinline__ Ctx make_ctx(LAS unsigned char* lds, int wave0) {
    Ctx C; C.lds = lds; C.lane = pg8::lane_id_v(); C.wave = wave0; C.tid = C.wave * 64 + C.lane;
    const int bx = opaque_s((int)blockIdx.x); C.G = opaque_s((int)gridDim.x); C.vcu = (C.G % 8 == 0) ? (bx % 8) * (C.G / 8) + bx / 8 : bx;
    C.gw = C.vcu * NWAVES + C.wave; C.ngw = C.G * NWAVES; return C;
}
__global__ void __launch_bounds__(NTHR, 2) fwd_kernel(Params K) {
    extern __shared__ __attribute__((aligned(16))) unsigned char lds_raw[];
    LAS unsigned char* const lds0 = (LAS unsigned char*)lds_raw;
    volatile LAS unsigned* MISC = (volatile LAS unsigned*)(lds0 + MISC_OFF);
    if (threadIdx.x < 64) MISC[threadIdx.x] = 0u;
    __syncthreads();
    (void)xcd_barrier_post((unsigned*)(K.ws + WS_CTL) + CW_BAR, MISC + 8);
    const int wave0 = __builtin_amdgcn_readfirstlane((int)threadIdx.x >> 6);
    const int lo = K.ph_lo, hi = K.ph_hi; int pidx = 0;
#ifndef PHMASK
#define PHMASK 0xFFFFFFFFu
#endif
#define EN(n) (((PHMASK) >> (n)) & 1u)
#ifndef DUPMASK
#define DUPMASK 0u
#endif
#define NREP(n) ((((DUPMASK) >> (n)) & 1u) ? 2 : 1)
#define PH_BEGIN(n) if (EN(n) && lo <= pidx && pidx < hi) { for (int rep_ = 0; rep_ < NREP(n); ++rep_) { const bool dup_first = NREP(n) > 1 && opaque_s(rep_) == 0; (void)dup_first; const PP P = make_pp(); const Ctx C = make_ctx(lds0, wave0); unsigned char* const ws = P.ws; float* const modb = (float*)(ws + WS_MOD); bf16* const X = (bf16*)(ws + WS_X); (void)modb; (void)X; (void)C;
#define PH_END if (pidx + 1 < hi || dup_first) { XcdBarrier b_; b_.bar = (unsigned*)(ws + WS_CTL) + CW_BAR; b_.x = xb_xcc_id(); b_.lead = (wave0 == 0 && pg8::lane_id_v() == 0) ? 1u : 0u; b_.st = (volatile LAS unsigned*)(lds0 + MISC_OFF) + 8; xcd_barrier(b_); } } } ++pidx;

    PH_BEGIN(0) p0_prologue(P, C); PH_END

    for (int l = 0; l < 4; ++l) {
        const int j = l >> 1;
        for (int half = 0; half < 2; ++half) {
            PH_BEGIN(1) phase_norm(P, C, l, half * 2); PH_END
            PH_BEGIN(2) { const char* A_ = (const char*)(ws + WS_H); const char* B_ = (const char*)(ws + WS_WFI) + (size_t)(l * 2 + half) * NFI * D * 2;
                { pg8::SchedFa S; S.A = A_; S.B = B_; S.G = C.G; S.c = opaque_s((int)blockIdx.x); S.tstep = (size_t)256 * D * 2;
                  pg8::EpiSwigluT<4> E{(bf16*)(ws + WS_U)};
                  pg8::gemm_phase<pg8::EpiSwigluT<4>, pg8::SchedFa, true, true, 4>(C.lds, D, S, E, C.tid); }
                { pg8::SchedFb S; S.A = A_; S.B = B_; S.G = C.G; S.c = opaque_s((int)blockIdx.x); S.tstep = (size_t)256 * D * 2;
                  pg8::EpiSwigluT<1> E{(bf16*)(ws + WS_U)};
                  pg8::gemm_phase<pg8::EpiSwigluT<1>, pg8::SchedFb, true, true, 1>(C.lds, D, S, E, C.tid); } } PH_END
            PH_BEGIN(3) { pg8::Sched1 S; S.A = (const char*)(ws + WS_U); S.B = (const char*)(ws + WS_WFO) + (size_t)(l * 2 + half) * D * DFF * 2; S.nM = M / 192; S.nN = D / 256; S.G = C.G; S.c = opaque_s((int)blockIdx.x); S.tstep = (size_t)192 * DFF * 2; S.tstepB = (size_t)256 * DFF * 2;
                pg8::EpiResidT<3> E{X, modb + (size_t)l * 5 * 18432 + (half ? 8 : 2) * D, dup_first ? 0.f : 0.5f};
                pg8::gemm_phase<pg8::EpiResidT<3>, pg8::Sched1, true, true, 3>(C.lds, DFF, S, E, C.tid); } PH_END
            if (half == 0) {
                PH_BEGIN(1) phase_norm(P, C, l, 1); PH_END
                if ((l & 1) == 0) {
#define wb (ws + WS_WMLA + (size_t)j * 20 * MiB)
                    PH_BEGIN(4) { pg8::Sched1 S; S.A = (const char*)(ws + WS_H); S.B = (const char*)wb; S.nM = M / 256; S.nN = 5; S.G = C.G; S.c = opaque_s((int)blockIdx.x); S.tstep = (size_t)256 * D * 2; S.tstepB = S.tstep;
                        pg8::EpiF32 E{(float*)(ws + A_RAW), 1280};
                        pg8::gemm_phase<pg8::EpiF32, pg8::Sched1, true, true>(C.lds, D, S, E, C.tid); } PH_END
                    PH_BEGIN(5) phase_mla_norm(P, C, j); PH_END
                    PH_BEGIN(6) { pg8::SchedM3 S; S.A0 = (const char*)(ws + A_CQ); S.B0 = (const char*)(wb + 5 * MiB); S.A1 = (const char*)(ws + A_CKV); S.B1 = (const char*)(wb + 8 * MiB);
                        S.nM0 = M / 256; S.nN0 = 12; S.nM1 = KVROWS / 256; S.nN1 = 16; S.G = C.G; S.c = opaque_s((int)blockIdx.x); S.tstep = (size_t)256 * 512 * 2;
                        pg8::EpiM3 E{(bf16*)(ws + A_Q), (bf16*)(ws + A_KV)};
                        pg8::gemm_phase<pg8::EpiM3, pg8::SchedM3, true, true>(C.lds, 512, S, E, C.tid); } PH_END
                    PH_BEGIN(8) phase_attn(P, C); PH_END
                    PH_BEGIN(9) { pg8::Sched1 S; S.A = (const char*)(ws + A_O); S.B = (const char*)(wb + 12 * MiB); S.nM = M / 192; S.nN = D / 256; S.G = C.G; S.c = opaque_s((int)blockIdx.x); S.tstep = (size_t)192 * D * 2; S.tstepB = (size_t)256 * D * 2;
                        pg8::EpiResidT<3> E{X, modb + (size_t)l * 5 * 18432 + 5 * D, dup_first ? 0.f : 1.0f};
                        pg8::gemm_phase<pg8::EpiResidT<3>, pg8::Sched1, true, true, 3>(C.lds, D, S, E, C.tid); } PH_END
                } else {
#undef wb
#define wb (ws + WS_WRW + (size_t)j * 42 * MiB)
                    PH_BEGIN(10) phase_shift(P, C, j); PH_END
                    PH_BEGIN(11) { pg8::SchedR2 S; S.A = (const char*)(ws + B_XMIX); S.B = (const char*)wb; S.nM = M / 256; S.G = C.G; S.c = opaque_s((int)blockIdx.x); S.tstep = (size_t)256 * D * 2; S.astride = (size_t)M * D * 2;
                        pg8::EpiR2 E{(bf16*)(ws + B_RKV), (size_t)M * D, (bf16*)(ws + B_T1), (size_t)M * 256, (size_t)M};
                        pg8::gemm_phase<pg8::EpiR2, pg8::SchedR2, true, true>(C.lds, D, S, E, C.tid); } PH_END
                    PH_BEGIN(12) { pg8::SchedR3 S; S.A = (const char*)(ws + B_T1); S.B = (const char*)(wb + 29 * MiB); S.nM = M / 256; S.G = C.G; S.c = opaque_s((int)blockIdx.x); S.tstep = (size_t)256 * 256 * 2; S.astride = (size_t)M * 256 * 2;
                        pg8::EpiR3 E{(bf16*)(ws + B_G), (bf16*)(ws + B_DEC), (bf16*)(ws + B_AA), (size_t)M * D, P.in[26] + (size_t)j * 2 * D, P.in[29] + (size_t)j * 2 * D, (size_t)M};
                        pg8::gemm_phase<pg8::EpiR3, pg8::SchedR3, true, true>(C.lds, 256, S, E, C.tid); } PH_END
                    PH_BEGIN(13) phase_scan(P, C, j, dup_first ? -1 : (l == 1 ? 0 : 1)); PH_END
                    PH_BEGIN(14) phase_post(P, C, j); PH_END
                    PH_BEGIN(15) { pg8::Sched1 S; S.A = (const char*)(ws + B_O2); S.B = (const char*)(wb + 34 * MiB); S.nM = M / 192; S.nN = D / 256; S.G = C.G; S.c = opaque_s((int)blockIdx.x); S.tstep = (size_t)192 * D * 2; S.tstepB = (size_t)256 * D * 2;
                        pg8::EpiResidT<3> E{X, modb + (size_t)l * 5 * 18432 + 5 * D, dup_first ? 0.f : 1.0f};
                        pg8::gemm_phase<pg8::EpiResidT<3>, pg8::Sched1, true, true, 3>(C.lds, D, S, E, C.tid); } PH_END
                }
            }
        }
    }
    PH_BEGIN(16) phase_final(P, C); PH_END
#undef PH_BEGIN
#undef wb
#undef PH_END
}

#ifndef MK_PER_PHASE
#define MK_PER_PHASE 0
#endif
constexpr int N_PHASES = 52;
extern "C" void kernel_launch(void* const* d_in, const int* in_sizes, int n_in, void* d_out, int out_size, void* d_ws, size_t ws_size, hipStream_t stream) {
    static int grid = 0;
    if (grid == 0) {
        if (n_in != 40 || out_size != (int)O_END || ws_size < WS_END) { fprintf(stderr, "kernel_launch: unexpected problem (n_in %d, out %d, ws %zu; need ws >= %zu); nothing launched\n", n_in, out_size, ws_size, (size_t)WS_END); grid = -1; return; }
        int dev = 0, cus = 0, per_cu = 0;
        if (hipGetDevice(&dev) != hipSuccess || hipDeviceGetAttribute(&cus, hipDeviceAttributeMultiprocessorCount, dev) != hipSuccess) { grid = -1; return; }
        if (hipFuncSetAttribute((const void*)fwd_kernel, hipFuncAttributeMaxDynamicSharedMemorySize, LDS_BYTES) != hipSuccess) { fprintf(stderr, "kernel_launch: hipFuncSetAttribute failed\n"); grid = -1; return; }
        if (hipOccupancyMaxActiveBlocksPerMultiprocessor(&per_cu, (const void*)fwd_kernel, NTHR, LDS_BYTES) != hipSuccess || per_cu < 1) { fprintf(stderr, "kernel_launch: occupancy query says %d\n", per_cu); }
        (void)hipGetLastError();
        grid = cus > 256 ? 256 : cus;
    }
    if (grid < 0) return;
    (void)hipMemsetAsync((char*)d_ws + WS_CTL, 0, CTL_ZERO_BYTES, stream);
    Params p{};
    for (int i = 0; i < 40; ++i) p.in[i] = (const float*)d_in[i];
    p.out = (float*)d_out; p.ws = (unsigned char*)d_ws;
#if MK_PER_PHASE
    for (int li = 0; li < N_PHASES; ++li) { p.ph_lo = li; p.ph_hi = li + 1; hipLaunchKernelGGL(fwd_kernel, dim3(grid), dim3(NTHR), LDS_BYTES, stream, p); }
#else
    p.ph_lo = 0; p.ph_hi = N_PHASES;
    hipLaunchKernelGGL(fwd_kernel, dim3(grid), dim3(NTHR), LDS_BYTES, stream, p);
#endif
}
```
